# Optimizing an MI355X kernel written in HIP

```python
import jax, jax.numpy as jnp
from jax import lax
import numpy as np

D_MODEL = 1024
BATCH = 16
SEQ = 256
DEPTH = 2
DEC_BATCH = 4
DEC_SEQ = 1024
PAST_LEN = 256

GRID_W = 64
HEAD_DIM = 64
BRANCH_DIM = D_MODEL // 2
A_Q_HEADS = BRANCH_DIM // HEAD_DIM
A_KV_HEADS = A_Q_HEADS // 4
A_GROUP = A_Q_HEADS // A_KV_HEADS
A_WINDOW = 128
A_BLOCK = 128
B_HEADS = BRANCH_DIM // HEAD_DIM
B_WIN_ROWS = 8
B_WIN_COLS = 16
C_GROUPS = 4
C_GROUP_DIM = BRANCH_DIM // C_GROUPS
N_BRANCH = 3
D_FF = -(-8 * D_MODEL // (3 * 256)) * 256
ROPE_BASE = 10000.0
NORM_EPS = 1e-6
NEG_INF = -1e30
IN_SIZES = (A_Q_HEADS * HEAD_DIM, A_KV_HEADS * HEAD_DIM, A_KV_HEADS * HEAD_DIM,
            B_HEADS * HEAD_DIM, B_HEADS * HEAD_DIM, B_HEADS * HEAD_DIM,
            BRANCH_DIM, N_BRANCH * D_MODEL)
IN_SPLITS = tuple(int(s) for s in np.cumsum(IN_SIZES)[:-1])
D_IN = int(sum(IN_SIZES))

kernel_name = "hybrid_flow_prefix_step"


def rms_norm(x, g):
    xf = x.astype(jnp.float32)
    y = xf * lax.rsqrt(jnp.mean(xf * xf, axis=-1, keepdims=True) + NORM_EPS)
    return (y * g.astype(jnp.float32)).astype(x.dtype)


def axial_rope(n_tokens):
    t = jnp.arange(n_tokens, dtype=jnp.int32)
    row = (t // GRID_W).astype(jnp.float32)
    col = (t % GRID_W).astype(jnp.float32)
    n_pairs_axis = HEAD_DIM // 4
    inv = ROPE_BASE ** (-jnp.arange(n_pairs_axis, dtype=jnp.float32) / n_pairs_axis)
    ang = jnp.concatenate([row[:, None] * inv, col[:, None] * inv], axis=-1)
    return jnp.cos(ang), jnp.sin(ang)


def apply_rope(x, cos, sin):
    half = HEAD_DIM // 2
    xf = x.astype(jnp.float32)
    x1, x2 = xf[..., :half], xf[..., half:]
    c = cos[None, :, None, :]
    s = sin[None, :, None, :]
    return jnp.concatenate([x1 * c - x2 * s, x1 * s + x2 * c], axis=-1).astype(x.dtype)


def sink_softmax(s, sink):
    m = jnp.maximum(jnp.max(s, axis=-1, keepdims=True), sink)
    e = jnp.exp(s - m)
    return e / (jnp.sum(e, axis=-1, keepdims=True) + jnp.exp(sink - m))


def combined_projection(h, w_in):
    B, T, _ = h.shape
    qa, ka, va, qb, kb, vb, uc, gates = jnp.split(h @ w_in, IN_SPLITS, axis=-1)
    heads = lambda z, n: z.reshape(B, T, n, HEAD_DIM)
    return (heads(qa, A_Q_HEADS), heads(ka, A_KV_HEADS), heads(va, A_KV_HEADS),
            heads(qb, B_HEADS), heads(kb, B_HEADS), heads(vb, B_HEADS), uc, gates)


def gqa_sink_context(q, k, v, sink):
    B, S = q.shape[:2]
    qg = q.reshape(B, S, A_KV_HEADS, A_GROUP, HEAD_DIM)
    s = jnp.einsum('bqkgd,bskd->bkgqs', qg, k, preferred_element_type=jnp.float32) * HEAD_DIM ** -0.5
    p = sink_softmax(s, sink.astype(jnp.float32).reshape(1, A_KV_HEADS, A_GROUP, 1, 1))
    o = jnp.einsum('bkgqs,bskd->bqkgd', p.astype(v.dtype), v)
    return o.reshape(B, S, A_Q_HEADS * HEAD_DIM)


def window_gqa_latent(q, k, v, ck, cv, sink):
    B, T = q.shape[:2]
    nb = T // A_BLOCK
    qb = q.reshape(B, nb, A_BLOCK, A_KV_HEADS, A_GROUP, HEAD_DIM)
    pad = ((0, 0), (A_BLOCK, A_BLOCK), (0, 0), (0, 0))
    kp = jnp.pad(k, pad)
    vp = jnp.pad(v, pad)
    idx = np.arange(nb)[:, None] * A_BLOCK + np.arange(3 * A_BLOCK)[None, :]
    kb = kp[:, idx]
    vb = vp[:, idx]
    qpos = np.arange(T).reshape(nb, A_BLOCK)
    kpos = idx - A_BLOCK
    valid = ((np.abs(qpos[:, :, None] - kpos[:, None, :]) <= A_WINDOW)
             & (kpos >= 0)[:, None, :] & (kpos < T)[:, None, :])
    scale = HEAD_DIM ** -0.5
    s_band = jnp.einsum('bnqkgd,bnskd->bnkgqs', qb, kb, preferred_element_type=jnp.float32) * scale
    s_band = jnp.where(valid[None, :, None, None], s_band, NEG_INF)
    s_ctx = jnp.einsum('bnqkgd,bpkd->bnkgqp', qb, ck, preferred_element_type=jnp.float32) * scale
    p = sink_softmax(jnp.concatenate([s_band, s_ctx], axis=-1),
                     sink.astype(jnp.float32).reshape(1, 1, A_KV_HEADS, A_GROUP, 1, 1))
    n_band = 3 * A_BLOCK
    o = (jnp.einsum('bnkgqs,bnskd->bnqkgd', p[..., :n_band].astype(v.dtype), vb)
         + jnp.einsum('bnkgqp,bpkd->bnqkgd', p[..., n_band:].astype(cv.dtype), cv))
    return o.reshape(B, T, A_Q_HEADS * HEAD_DIM)


def mha_context(q, k, v):
    B, S = q.shape[:2]
    s = jnp.einsum('bqhd,bshd->bhqs', q, k, preferred_element_type=jnp.float32) * HEAD_DIM ** -0.5
    p = jax.nn.softmax(s, axis=-1)
    o = jnp.einsum('bhqs,bshd->bqhd', p.astype(v.dtype), v)
    return o.reshape(B, S, B_HEADS * HEAD_DIM)


def neighbourhood_latent(q, k, v, ck, cv, rpb):
    B, T, H, D = q.shape
    rows = T // GRID_W
    kr = min(B_WIN_ROWS, rows)
    kc = B_WIN_COLS
    reg = 2 * kc
    ncb = GRID_W // kc
    cols = np.arange(GRID_W)
    win_start = np.clip(cols - kc // 2, 0, GRID_W - kc)
    reg_cols = np.clip(np.arange(ncb) * kc - kc // 2, 0, GRID_W - reg)[:, None] + np.arange(reg)
    q_cols = cols.reshape(ncb, kc)
    ws = win_start[q_cols][:, :, None]
    col_ok = (reg_cols[:, None, :] >= ws) & (reg_cols[:, None, :] < ws + kc)
    dc_idx = np.clip(reg_cols[:, None, :] - q_cols[:, :, None] + B_WIN_COLS - 1, 0, 2 * B_WIN_COLS - 2)
    scale = HEAD_DIM ** -0.5
    qg = q.reshape(B, rows, GRID_W, H, D)
    kg = k.reshape(B, rows, GRID_W, H, D)
    vg = v.reshape(B, rows, GRID_W, H, D)
    n_loc = kr * reg

    def row_block(r):
        r0 = jnp.clip(r - kr // 2, 0, rows - kr)
        k_reg = lax.dynamic_slice_in_dim(kg, r0, kr, axis=1)[:, :, reg_cols]
        v_reg = lax.dynamic_slice_in_dim(vg, r0, kr, axis=1)[:, :, reg_cols]
        q_blk = lax.dynamic_index_in_dim(qg, r, axis=1, keepdims=False).reshape(B, ncb, kc, H, D)
        s_loc = jnp.einsum('bnqhd,bmnshd->bhnqms', q_blk, k_reg, preferred_element_type=jnp.float32) * scale
        row_idx = (r0 + jnp.arange(kr) - r + B_WIN_ROWS - 1)[None, None, :, None]
        bias = rpb[:, row_idx, dc_idx[:, :, None, :]].astype(jnp.float32)
        s_loc = jnp.where(col_ok[None, None, :, :, None, :], s_loc + bias[None], NEG_INF)
        s_loc = s_loc.reshape(B, H, ncb, kc, n_loc)
        s_ctx = jnp.einsum('bnqhd,bphd->bhnqp', q_blk, ck, preferred_element_type=jnp.float32) * scale
        p = jax.nn.softmax(jnp.concatenate([s_loc, s_ctx], axis=-1), axis=-1)
        p_loc = p[..., :n_loc].reshape(B, H, ncb, kc, kr, reg).astype(v.dtype)
        o = (jnp.einsum('bhnqms,bmnshd->bnqhd', p_loc, v_reg)
             + jnp.einsum('bhnqp,bphd->bnqhd', p[..., n_loc:].astype(cv.dtype), cv))
        return o.reshape(B, GRID_W, H * D)

    o = lax.map(row_block, jnp.arange(rows))
    return jnp.moveaxis(o, 0, 1).reshape(B, T, H * D)


def fourier_mix(u):
    B, T, _ = u.shape
    ug = u.reshape(B, T, C_GROUPS, C_GROUP_DIM).astype(jnp.float32)
    f = jnp.fft.fft2(ug, axes=(1, 3), norm='ortho').real
    return f.reshape(B, T, BRANCH_DIM).astype(u.dtype)


def merge_branches(oa, ob, oc, gates, w_branch, w_out):
    ga, gb, gc = jnp.split(gates, N_BRANCH, axis=-1)
    m = (jax.nn.sigmoid(ga) * (oa @ w_branch[0]) + jax.nn.sigmoid(gb) * (ob @ w_branch[1])
         + jax.nn.sigmoid(gc) * (oc @ w_branch[2]))
    return m @ w_out


def swiglu(h, w_ffn_in, w_ffn_out):
    g, u = jnp.split(h @ w_ffn_in, 2, axis=-1)
    return (jax.nn.silu(g) * u) @ w_ffn_out


def trunk_layer(x, mod, g_pre, g_post, w_in_l, w_branch_l, w_out_l, w_ffn_in_l, w_ffn_out_l, attend):
    sh1, sc1, g1, sh2, sc2, g2 = jnp.split(mod, 6, axis=-1)
    h = rms_norm(x, g_pre[0]) * (1 + sc1) + sh1
    qa, ka, va, qb, kb, vb, uc, gates = combined_projection(h, w_in_l)
    oa, ob = attend(qa, ka, va, qb, kb, vb)
    oc = fourier_mix(uc)
    y = merge_branches(oa, ob, oc, gates, w_branch_l, w_out_l)
    x = x + g1 * rms_norm(y, g_post[0])
    h = rms_norm(x, g_pre[1]) * (1 + sc2) + sh2
    x = x + g2 * rms_norm(swiglu(h, w_ffn_in_l, w_ffn_out_l), g_post[1])
    return x, (ka, va, kb, vb)


def setup_inputs(seed: int = 0) -> dict:
    key = jax.random.key(seed)
    ks = jax.random.split(key, 19)
    f32 = jnp.float32
    nrm = lambda k, shape, s: jax.random.normal(k, shape, f32) * s
    return {
        "x_prompt": nrm(ks[0], (BATCH, SEQ, D_MODEL), 1.0),
        "x_sample": nrm(ks[1], (DEC_BATCH, DEC_SEQ, D_MODEL), 1.0),
        "cache_a_k": nrm(ks[2], (DEC_BATCH, DEPTH, PAST_LEN, A_KV_HEADS, HEAD_DIM), 1.0),
        "cache_a_v": nrm(ks[3], (DEC_BATCH, DEPTH, PAST_LEN, A_KV_HEADS, HEAD_DIM), 1.0),
        "cache_b_k": nrm(ks[4], (DEC_BATCH, DEPTH, PAST_LEN, B_HEADS, HEAD_DIM), 1.0),
        "cache_b_v": nrm(ks[5], (DEC_BATCH, DEPTH, PAST_LEN, B_HEADS, HEAD_DIM), 1.0),
        "c": nrm(ks[6], (DEC_BATCH, D_MODEL), 1.0),
        "c_ctx": nrm(ks[7], (D_MODEL,), 1.0),
        "w_ada": nrm(ks[8], (DEPTH, D_MODEL, 6 * D_MODEL), 0.5 * D_MODEL ** -0.5),
        "b_ada": nrm(ks[9], (DEPTH, 6 * D_MODEL), 0.02),
        "norm_pre": 1.0 + nrm(ks[10], (DEPTH, 2, D_MODEL), 0.02),
        "norm_post": 1.0 + nrm(ks[11], (DEPTH, 2, D_MODEL), 0.02),
        "w_in": nrm(ks[12], (DEPTH, D_MODEL, D_IN), D_MODEL ** -0.5),
        "a_sink": nrm(ks[13], (DEPTH, A_Q_HEADS), 1.0),
        "b_rpb": nrm(ks[14], (DEPTH, B_HEADS, 2 * B_WIN_ROWS - 1, 2 * B_WIN_COLS - 1), 0.1),
        "w_branch": nrm(ks[15], (DEPTH, N_BRANCH, BRANCH_DIM, D_MODEL), BRANCH_DIM ** -0.5),
        "w_out": nrm(ks[16], (DEPTH, D_MODEL, D_MODEL), D_MODEL ** -0.5),
        "w_ffn_in": nrm(ks[17], (DEPTH, D_MODEL, 2 * D_FF), D_MODEL ** -0.5),
        "w_ffn_out": nrm(ks[18], (DEPTH, D_FF, D_MODEL), D_FF ** -0.5),
    }


def reference(x_prompt, x_sample, cache_a_k, cache_a_v, cache_b_k, cache_b_v, c, c_ctx,
              w_ada, b_ada, norm_pre, norm_post, w_in, a_sink, b_rpb, w_branch, w_out,
              w_ffn_in, w_ffn_out):
    x = x_prompt
    ak, av, bk, bv = [], [], [], []
    for l in range(DEPTH):
        mod = jax.nn.silu(c_ctx) @ w_ada[l] + b_ada[l]
        x, (ka, va, kb, vb) = trunk_layer(
            x, mod, norm_pre[l], norm_post[l], w_in[l], w_branch[l], w_out[l], w_ffn_in[l], w_ffn_out[l],
            lambda qa, ka, va, qb, kb, vb: (gqa_sink_context(qa, ka, va, a_sink[l]), mha_context(qb, kb, vb)))
        ak.append(ka)
        av.append(va)
        bk.append(kb)
        bv.append(vb)
    y_prompt = x
    new_a_k = jnp.stack(ak, axis=1)
    new_a_v = jnp.stack(av, axis=1)
    new_b_k = jnp.stack(bk, axis=1)
    new_b_v = jnp.stack(bv, axis=1)

    cos, sin = axial_rope(x_sample.shape[1])
    x = x_sample
    for l in range(DEPTH):
        mod = (jax.nn.silu(c) @ w_ada[l] + b_ada[l])[:, None, :]
        x, _ = trunk_layer(
            x, mod, norm_pre[l], norm_post[l], w_in[l], w_branch[l], w_out[l], w_ffn_in[l], w_ffn_out[l],
            lambda qa, ka, va, qb, kb, vb: (
                window_gqa_latent(apply_rope(qa, cos, sin), apply_rope(ka, cos, sin), va,
                                  cache_a_k[:, l], cache_a_v[:, l], a_sink[l]),
                neighbourhood_latent(qb, kb, vb, cache_b_k[:, l], cache_b_v[:, l], b_rpb[l])))
    y_sample = x
    return (y_prompt, y_sample, new_a_k, new_a_v, new_b_k, new_b_v)
```

```cpp
#include <hip/hip_runtime.h>
#include <cstdio>
#include <cstdint>

#ifndef MK_PER_PHASE
#define MK_PER_PHASE 0
#endif

#ifndef DIS
#define DIS 0
#endif
#ifndef PROBE_PH
#define PROBE_PH -1
#define PROBE_REP 1
#endif
#ifndef PROBE_HI
#define PROBE_HI PROBE_PH
#endif
#ifndef FUSED_ROWS
#define FUSED_ROWS 1
#endif
#ifndef PROBE_EPI
#define PROBE_EPI 0
#endif
#ifndef PROBE_BAR
#define PROBE_BAR 0
#endif
#ifndef PROBE_TWICE
#define PROBE_TWICE 0
#endif
#ifndef PREREAD
#define PREREAD 0
#endif
#ifndef PROBE_SKIP
#define PROBE_SKIP 0
#endif
#define LAS __attribute__((address_space(3)))
#define GAS __attribute__((address_space(1)))
typedef unsigned short bf16_t;
typedef short bf16x8 __attribute__((ext_vector_type(8)));
typedef short s16x4 __attribute__((ext_vector_type(4)));
typedef float f32x4 __attribute__((ext_vector_type(4)));
typedef float f32x2 __attribute__((ext_vector_type(2)));
typedef float f32x16 __attribute__((ext_vector_type(16)));
typedef unsigned u32x4 __attribute__((ext_vector_type(4)));
typedef unsigned u32x2 __attribute__((ext_vector_type(2)));
typedef __bf16 bf16x2_t __attribute__((ext_vector_type(2)));

constexpr int DM = 1024, NTOK = 8192, NCTX = 4096, DEPTH = 2, DIN = 5888, DFF = 2816, DFF2 = 5632;
constexpr int OUT_NAK = 8388608, OUT_NAV = 9437184, OUT_NBK = 10485760, OUT_NBV = 14680064, OUT_TOTAL = 18874368;
constexpr float LOG2E = 1.4426950408889634f;
constexpr float QSCALE = 0.125f * LOG2E;
constexpr float NORM_EPS = 1e-6f;
constexpr float NEGBIG = -1e30f, MINIT = -1e20f;

constexpr size_t MiB = 1u << 20;
constexpr size_t WS_CTL = 0, CTL_ZERO_BYTES = 64 * 1024;
constexpr size_t WS_MOD = 1 * MiB;
constexpr size_t WS_ROPEC = 1 * MiB + 256 * 1024;
constexpr size_t WS_ROPES = 1 * MiB + 384 * 1024;
constexpr size_t WS_DFTC = 2 * MiB;
constexpr size_t WS_CKA = 3 * MiB, WS_CVAT = 3 * MiB + 512 * 1024;
constexpr size_t WS_CKB = 4 * MiB, WS_CVBT = 6 * MiB;
constexpr size_t WS_DFTL = 8 * MiB;
constexpr size_t WS_W = 12 * MiB, W_LAYER = 34 * MiB;
constexpr size_t W_IN = 0, W_BR = 11 * MiB + 512 * 1024, W_OUT = W_BR + 4 * MiB, W_F1 = W_OUT + 2 * MiB, W_F2 = W_F1 + 11 * MiB;
constexpr size_t WS_H = 80 * MiB;
constexpr size_t WS_QA = 96 * MiB, WS_KA = 104 * MiB, WS_VAT = 106 * MiB, WS_QB = 108 * MiB, WS_KB = 116 * MiB, WS_VBT = 124 * MiB, WS_UT = 132 * MiB;
constexpr size_t WS_MB = 96 * MiB;
constexpr size_t WS_G = 140 * MiB;
constexpr size_t WS_AB = 140 * MiB;
constexpr size_t WS_OC = 188 * MiB;
constexpr size_t WS_Y = 188 * MiB;
constexpr size_t WS_END = 220 * MiB;
static_assert(W_F2 + 5 * MiB + 512 * 1024 == W_LAYER, "weight map");
constexpr size_t WS_XS = 1 * MiB + 512 * 1024;
constexpr int CW_XCNT = 8192;
constexpr int CW_MODCNT = 512;
constexpr int CW_BAR = 1024;

constexpr int RING_BYTES = 147456;
constexpr int LDSCTL_OFF = RING_BYTES, MISC_OFF = LDSCTL_OFF + 320;
constexpr int TW_OFF = RING_BYTES + 1024;
constexpr int EXCH_OFF = 155648;
constexpr int LDS_BYTES = 163840;
constexpr int NWAVES = 8;

__device__ __forceinline__ unsigned f2bf(float f) { unsigned u = __builtin_bit_cast(unsigned, f); return (u + 0x7fffu + ((u >> 16) & 1u)) >> 16; }
__device__ __forceinline__ unsigned pk2(float lo, float hi) { f32x2 v = {lo, hi}; bf16x2_t b = __builtin_convertvector(v, bf16x2_t); return __builtin_bit_cast(unsigned, b); }
__device__ __forceinline__ u32x2 pk4(f32x4 v) { u32x2 r; r.x = pk2(v[0], v[1]); r.y = pk2(v[2], v[3]); return r; }
__device__ __forceinline__ void st8(void* p, u32x2 v) { *(u32x2*)p = v; }
__device__ __forceinline__ void st16f(float* p, f32x4 v) { *(f32x4*)p = v; }
__device__ __forceinline__ void st16u(void* p, u32x4 v) { *(u32x4*)p = v; }
__device__ __forceinline__ void st2(bf16_t* p, unsigned v) { *p = (bf16_t)v; }
__device__ __forceinline__ float bf2f(unsigned short b) { return __builtin_bit_cast(float, (unsigned)b << 16); }
__device__ __forceinline__ f32x4 ld_bf4(const bf16_t* p) { const u32x2 w = *(const u32x2*)p; f32x4 r; r[0] = __builtin_bit_cast(float, w.x << 16); r[1] = __builtin_bit_cast(float, w.x & 0xffff0000u);
    r[2] = __builtin_bit_cast(float, w.y << 16); r[3] = __builtin_bit_cast(float, w.y & 0xffff0000u); return r; }
__device__ __forceinline__ float shx(float v, int o, int lane) { return __builtin_bit_cast(float, __builtin_amdgcn_ds_bpermute((lane ^ o) << 2, __builtin_bit_cast(int, v))); }
__device__ __forceinline__ float wave_sum(float v, int lane) {
#pragma unroll
    for (int o = 1; o < 64; o <<= 1) v += shx(v, o, lane);
    return v;
}
__device__ __forceinline__ float fast_rcp(float x) { return __builtin_amdgcn_rcpf(x); }
__device__ __forceinline__ float sigmoidf_(float x) { x = fminf(fmaxf(x, -30.f), 30.f); return fast_rcp(1.f + __builtin_amdgcn_exp2f(-x * LOG2E)); }

__device__ __forceinline__ int opaque_tid() { int t = threadIdx.x; asm volatile("" : "+v"(t)); return t; }
namespace pg8 {
constexpr int BM = 256, BK = 64, HALF = 128, HTB = HALF * BK * 2, STAGE_BYTES = 8 * HTB, NXCD = 8, WGM = 8;
__host__ __device__ __forceinline__ int lds_byte(int r, int c) { const int st = (r >> 4) * 2 + (c >> 5), rr = r & 15, cc = c & 31, ob = rr * 64 + cc * 2; return st * 1024 + (ob ^ (((ob >> 9) & 1) << 5)); }
__host__ __device__ __forceinline__ void stage_rc(int b, int& R, int& C) { const int st = b / 1024, sb = b % 1024, swz = sb ^ (((sb >> 9) & 1) << 5); R = (st >> 1) * 16 + swz / 64; C = (st & 1) * 32 + (swz % 64) / 2; }

struct Unit { int pm, pn, tag; unsigned A, B; };
struct Dims { int K, lda, ldb; };

__device__ __forceinline__ void tile_of(int L, int nM, int nN, int& pm, int& pn) {
    const int nwg = nM * nN; int wgid = L;
    { const int q = nwg / NXCD, r = nwg % NXCD, xcd = wgid % NXCD, off = wgid / NXCD; wgid = (xcd < r ? xcd * (q + 1) : r * (q + 1) + (xcd - r) * q) + off; }
    const int nig = WGM * nN, gid = wgid / nig, fm = gid * WGM, gsz = (nM - fm) < WGM ? (nM - fm) : WGM;
    pm = fm + ((wgid % nig) % gsz); pn = (wgid % nig) / gsz;
}
__device__ __forceinline__ bool tile_local(int i, int c, int mpx, int nN, int& pm, int& pn) {
    const int L = i * 32 + (c & 31); if (L >= mpx * nN) return false;
    pm = (c >> 5) * mpx + (L & (mpx - 1)); pn = L / mpx; return true; }
struct GridSched {
    unsigned A, B; int nM, nN, G, c; unsigned tA, tB; int lm;
    __device__ __forceinline__ bool next(int i, Unit& u) const {
        if (lm) { if (!tile_local(i, c, nM >> 3, nN, u.pm, u.pn)) return false; }
        else { const int L = i * G + c; if (L >= nM * nN) return false; tile_of(L, nM, nN, u.pm, u.pn); }
        u.tag = 0; u.A = A + (unsigned)u.pm * tA; u.B = B + (unsigned)u.pn * tB; return true;
    }
};

template <class Epi, class Sched>
__device__ __forceinline__ void gemm_phase(LAS unsigned char* lds, const unsigned char* wsb, const Dims g, const Sched& S, const Epi& E) {
    const int tid = opaque_tid(), wid = __builtin_amdgcn_readfirstlane(tid >> 6), lane = tid & 63, wr = wid >> 2, wc = wid & 3, fr = lane & 15, fq = lane >> 4;
    int K = g.K, lda_ = g.lda, ldb_ = g.ldb;
    asm volatile("" : "+s"(K), "+s"(lda_), "+s"(ldb_));
    const int nt = K / BK;
    unsigned voffA, voffB;
    { int R, C; stage_rc(tid * 16, R, C); voffA = (unsigned)(R * lda_ + C) * 2u; voffB = (unsigned)(R * ldb_ + C) * 2u; }
    const unsigned qvoffA = 64u * lda_ * 2u, qvoffB = 64u * ldb_ * 2u;
    constexpr unsigned kstep = BK * 2;
    constexpr int aux_voffA = 0, aux_voffB = 0;
    const unsigned hstepA = (unsigned)HALF * lda_ * 2u, hstepB = (unsigned)HALF * ldb_ * 2u;
    const unsigned ldsw = (unsigned)wid * 1024u;
    const int aoff = lds_byte(wr * 64 + fr, fq * 8), boff = lds_byte(wc * 32 + fr, fq * 8);
#define PG8_SA(b, h) (((b) * 2 + (h)) * HTB)
#define PG8_SB(b, h) ((4 + (b) * 2 + (h)) * HTB)
#define PG8_STAGE(bufoff, gbase, voff) do { _Pragma("unroll") for (int _i = 0; _i < 2; ++_i) \
        __builtin_amdgcn_global_load_lds((const unsigned*)((const char*)wsb + (size_t)((gbase) + _i * q##voff) + (voff)), (LAS unsigned*)(lds + (bufoff) + ldsw + _i * 8192), 16, 0, aux_##voff); } while (0)
#define PG8_LDA(dst, b, h) do { _Pragma("unroll") for (int m = 0; m < 4; ++m) _Pragma("unroll") for (int k = 0; k < 2; ++k) dst[m][k] = *(const LAS bf16x8*)(lds + PG8_SA(b, h) + aoff + m * 2048 + k * 1024); } while (0)
#define PG8_LDB(dst, b, h) do { _Pragma("unroll") for (int n = 0; n < 2; ++n) _Pragma("unroll") for (int k = 0; k < 2; ++k) dst[n][k] = *(const LAS bf16x8*)(lds + PG8_SB(b, h) + boff + n * 2048 + k * 1024); } while (0)
#define PG8_MMA(ai, bj, At, Bt) do { __builtin_amdgcn_s_setprio(1); _Pragma("unroll") for (int m = 0; m < 4; ++m) _Pragma("unroll") for (int n = 0; n < 2; ++n) _Pragma("unroll") for (int k = 0; k < 2; ++k) \
        acc[ai][bj][m][n] = __builtin_amdgcn_mfma_f32_16x16x32_bf16(Bt[n][k], At[m][k], acc[ai][bj][m][n], 0, 0, 0); __builtin_amdgcn_s_setprio(0); } while (0)
#define PG8_WAIT_V(n) asm volatile("s_waitcnt vmcnt(" #n ")" ::: "memory")
#define PG8_WAIT_L(n) asm volatile("s_waitcnt lgkmcnt(" #n ")" ::: "memory")
#define PG8_BAR __builtin_amdgcn_s_barrier()
#define PG8_SCHED __builtin_amdgcn_sched_barrier(0)
    Unit cur, nxt; int ui = 0;
    if (!S.next(0, cur)) return;
    f32x4 acc[2][2][4][2];
#pragma unroll
    for (int a = 0; a < 2; ++a)
#pragma unroll
        for (int b = 0; b < 2; ++b)
#pragma unroll
            for (int m = 0; m < 4; ++m)
#pragma unroll
                for (int n = 0; n < 2; ++n) acc[a][b][m][n] = (f32x4){0.f, 0.f, 0.f, 0.f};
    bf16x8 At[4][2], B0[2][2], B1[2][2];
    unsigned cA = cur.A, cB = cur.B;
    PG8_STAGE(PG8_SB(0, 0), cB, voffB); PG8_STAGE(PG8_SB(0, 1), cB + hstepB, voffB); PG8_STAGE(PG8_SA(0, 0), cA, voffA); PG8_STAGE(PG8_SA(0, 1), cA + hstepA, voffA);
    if (wr == 1) PG8_BAR;
    PG8_WAIT_V(2); PG8_BAR;
    PG8_STAGE(PG8_SB(1, 0), cB + kstep, voffB); PG8_STAGE(PG8_SA(1, 0), cA + kstep, voffA); PG8_STAGE(PG8_SB(1, 1), cB + hstepB + kstep, voffB);
    PG8_WAIT_V(6); PG8_BAR;
    for (;;) {
        const bool has_next = S.next(ui + 1, nxt);
        const unsigned nA = has_next ? nxt.A : cA, nB = has_next ? nxt.B : cB;
        for (int t = 0; t < nt; t += 2) {
            const bool last = (t == nt - 2);
            const unsigned a1 = cA + (unsigned)(t + 1) * kstep;
            const unsigned a2 = last ? nA : cA + (unsigned)(t + 2) * kstep, b2 = last ? nB : cB + (unsigned)(t + 2) * kstep;
            const unsigned a3 = a2 + kstep, b3 = b2 + kstep;
            PG8_LDB(B0, 0, 0); PG8_LDB(B1, 0, 1); PG8_SCHED; PG8_LDA(At, 0, 0); PG8_STAGE(PG8_SA(1, 1), a1 + hstepA, voffA);
            PG8_WAIT_V(8); PG8_WAIT_L(0); PG8_BAR; PG8_MMA(0, 0, At, B0); PG8_MMA(0, 1, At, B1); PG8_BAR; PG8_SCHED;
            PG8_LDA(At, 0, 1); PG8_STAGE(PG8_SB(0, 0), b2, voffB); PG8_STAGE(PG8_SB(0, 1), b2 + hstepB, voffB); PG8_STAGE(PG8_SA(0, 0), a2, voffA);
            PG8_WAIT_V(8); PG8_WAIT_L(0); PG8_BAR; PG8_MMA(1, 0, At, B0); PG8_MMA(1, 1, At, B1); PG8_BAR; PG8_SCHED;
            PG8_LDB(B0, 1, 0); PG8_LDB(B1, 1, 1); PG8_SCHED; PG8_LDA(At, 1, 0); PG8_STAGE(PG8_SA(0, 1), a2 + hstepA, voffA);
            PG8_WAIT_V(8); PG8_WAIT_L(0); PG8_BAR; PG8_MMA(0, 0, At, B0); PG8_MMA(0, 1, At, B1); PG8_BAR; PG8_SCHED;
            PG8_LDA(At, 1, 1); PG8_STAGE(PG8_SB(1, 0), b3, voffB); PG8_STAGE(PG8_SB(1, 1), b3 + hstepB, voffB); PG8_STAGE(PG8_SA(1, 0), a3, voffA);
            PG8_WAIT_V(8); PG8_WAIT_L(0); PG8_BAR; PG8_MMA(1, 0, At, B0); PG8_MMA(1, 1, At, B1); PG8_BAR; PG8_SCHED;
        }
        if (wr == 0) PG8_BAR;
        const bool keep = E.template run<2>(acc, cur, wr, wc, fr, fq);
        if (!has_next) break;
        if (!keep) {
#pragma unroll
            for (int a = 0; a < 2; ++a)
#pragma unroll
                for (int b = 0; b < 2; ++b)
#pragma unroll
                    for (int m = 0; m < 4; ++m)
#pragma unroll
                        for (int n = 0; n < 2; ++n) acc[a][b][m][n] = (f32x4){0.f, 0.f, 0.f, 0.f};
        }
        cur = nxt; cA = nA; cB = nB; ++ui;
        if (wr == 1) PG8_BAR;
    }
    PG8_WAIT_V(0);
    PG8_BAR;
#undef PG8_SA
#undef PG8_SB
#undef PG8_STAGE
#undef PG8_LDA
#undef PG8_LDB
#undef PG8_MMA
#undef PG8_WAIT_V
#undef PG8_WAIT_L
#undef PG8_BAR
#undef PG8_SCHED
}


template <class Epi, class Sched>
__device__ __forceinline__ void gemm_phase_hm(LAS unsigned char* lds, const unsigned char* wsb, const Dims g, const Sched& S, const Epi& E) {
    const int tid = opaque_tid(), wid = __builtin_amdgcn_readfirstlane(tid >> 6), lane = tid & 63, wr = wid >> 2, wc = wid & 3, fr = lane & 15, fq = lane >> 4;
    int K = g.K, lda_ = g.lda, ldb_ = g.ldb;
    asm volatile("" : "+s"(K), "+s"(lda_), "+s"(ldb_));
    const int nt = K / BK;
    unsigned voffA, voffB;
    { int R, C; stage_rc(tid * 16, R, C); voffA = (unsigned)(R * lda_ + C) * 2u; voffB = (unsigned)(R * ldb_ + C) * 2u; }
    const unsigned qvoffA = 64u * lda_ * 2u, qvoffB = 64u * ldb_ * 2u;
    constexpr unsigned kstep = BK * 2;
    constexpr int aux_voffA = 0, aux_voffB = 0;
    const unsigned hstepB = (unsigned)HALF * ldb_ * 2u;
    const unsigned ldsw = (unsigned)wid * 1024u;
    const int aoff = lds_byte(wr * 64 + fr, fq * 8), boff = lds_byte(wc * 32 + fr, fq * 8);
    constexpr int SLOT = 3 * HTB;
#define HM_STAGE(bufoff, gbase, voff) do { _Pragma("unroll") for (int _i = 0; _i < 2; ++_i) \
        __builtin_amdgcn_global_load_lds((const unsigned*)((const char*)wsb + (size_t)((gbase) + _i * q##voff) + (voff)), (LAS unsigned*)(lds + (bufoff) + ldsw + _i * 8192), 16, 0, aux_##voff); } while (0)
#define HM_STAGE3(so, gb, ga) do { HM_STAGE((so), (gb), voffB); HM_STAGE((so) + HTB, (gb) + hstepB, voffB); HM_STAGE((so) + 2 * HTB, (ga), voffA); } while (0)
#define HM_LDA(dst, so) do { _Pragma("unroll") for (int m = 0; m < 4; ++m) _Pragma("unroll") for (int k = 0; k < 2; ++k) dst[m][k] = *(const LAS bf16x8*)(lds + (so) + 2 * HTB + aoff + m * 2048 + k * 1024); } while (0)
#define HM_LDB(dst, so, h) do { _Pragma("unroll") for (int n = 0; n < 2; ++n) _Pragma("unroll") for (int k = 0; k < 2; ++k) dst[n][k] = *(const LAS bf16x8*)(lds + (so) + (h) * HTB + boff + n * 2048 + k * 1024); } while (0)
#define HM_MMA(bj, At, Bt) do { __builtin_amdgcn_s_setprio(1); _Pragma("unroll") for (int m = 0; m < 4; ++m) _Pragma("unroll") for (int n = 0; n < 2; ++n) _Pragma("unroll") for (int k = 0; k < 2; ++k) \
        acc[0][bj][m][n] = __builtin_amdgcn_mfma_f32_16x16x32_bf16(Bt[n][k], At[m][k], acc[0][bj][m][n], 0, 0, 0); __builtin_amdgcn_s_setprio(0); } while (0)
#define HM_WAIT_V(n) asm volatile("s_waitcnt vmcnt(" #n ")" ::: "memory")
#define HM_WAIT_L(n) asm volatile("s_waitcnt lgkmcnt(" #n ")" ::: "memory")
#define HM_BAR __builtin_amdgcn_s_barrier()
#define HM_SCHED __builtin_amdgcn_sched_barrier(0)
    Unit cur, nxt; int ui = 0;
    if (!S.next(0, cur)) return;
    f32x4 acc[1][2][4][2];
#pragma unroll
    for (int b = 0; b < 2; ++b)
#pragma unroll
        for (int m = 0; m < 4; ++m)
#pragma unroll
            for (int n = 0; n < 2; ++n) acc[0][b][m][n] = (f32x4){0.f, 0.f, 0.f, 0.f};
    bf16x8 At[4][2], B0[2][2], B1[2][2];
    unsigned cA = cur.A, cB = cur.B;
    HM_STAGE3(0, cB, cA);
    if (wr == 1) HM_BAR;
    HM_WAIT_V(0); HM_BAR;
    HM_STAGE3(SLOT, cB + kstep, cA + kstep);
    HM_BAR;
    int rs = 0;
    for (;;) {
        const bool has_next = S.next(ui + 1, nxt);
        const unsigned nA = has_next ? nxt.A : cA, nB = has_next ? nxt.B : cB;
        for (int t = 0; t < nt; ++t) {
            const unsigned a2 = (t + 2 < nt) ? cA + (unsigned)(t + 2) * kstep : nA + (unsigned)(t + 2 - nt) * kstep;
            const unsigned b2 = (t + 2 < nt) ? cB + (unsigned)(t + 2) * kstep : nB + (unsigned)(t + 2 - nt) * kstep;
            const int so = rs * SLOT, sn = (rs == 0 ? 2 : rs - 1) * SLOT;
            HM_LDB(B0, so, 0); HM_LDB(B1, so, 1); HM_SCHED; HM_LDA(At, so); HM_STAGE3(sn, b2, a2);
            HM_WAIT_V(6); HM_WAIT_L(0); HM_BAR; HM_MMA(0, At, B0); HM_MMA(1, At, B1); HM_BAR; HM_SCHED;
            rs = rs == 2 ? 0 : rs + 1;
        }
        if (wr == 0) HM_BAR;
        const bool keep = E.template run<1>(acc, cur, wr, wc, fr, fq);
        if (!has_next) break;
        if (!keep) {
#pragma unroll
            for (int b = 0; b < 2; ++b)
#pragma unroll
                for (int m = 0; m < 4; ++m)
#pragma unroll
                    for (int n = 0; n < 2; ++n) acc[0][b][m][n] = (f32x4){0.f, 0.f, 0.f, 0.f};
        }
        cur = nxt; cA = nA; cB = nB; ++ui;
        if (wr == 1) HM_BAR;
    }
    HM_WAIT_V(0);
    HM_BAR;
#undef HM_STAGE
#undef HM_STAGE3
#undef HM_LDA
#undef HM_LDB
#undef HM_MMA
#undef HM_WAIT_V
#undef HM_WAIT_L
#undef HM_BAR
#undef HM_SCHED
}

struct EpiF32 { float* O; int ldc;
    template <int NAI> __device__ __forceinline__ bool run(f32x4 (&acc)[NAI][2][4][2], const Unit& u, int wr, int wc, int fr, int fq) const {
        const int row0 = u.pm * (HALF * NAI) + wr * 64 + fr, col0 = u.pn * BM + wc * 32 + 4 * fq;
#pragma unroll
        for (int ai = 0; ai < NAI; ++ai)
#pragma unroll
            for (int m = 0; m < 4; ++m) { float* rp = O + (size_t)(row0 + ai * HALF + m * 16) * ldc + col0;
#pragma unroll
                for (int bj = 0; bj < 2; ++bj)
#pragma unroll
                    for (int n = 0; n < 2; ++n) st16f(rp + bj * HALF + n * 16, acc[ai][bj][m][n]); }
        return false; } };
struct EpiBf16 { bf16_t* O; int ldc;
    template <int NAI> __device__ __forceinline__ bool run(f32x4 (&acc)[NAI][2][4][2], const Unit& u, int wr, int wc, int fr, int fq) const {
        const int row0 = u.pm * (HALF * NAI) + wr * 64 + fr, col0 = u.pn * BM + wc * 32 + 4 * fq;
#pragma unroll
        for (int ai = 0; ai < NAI; ++ai)
#pragma unroll
            for (int m = 0; m < 4; ++m) { bf16_t* rp = O + (size_t)(row0 + ai * HALF + m * 16) * ldc + col0;
#pragma unroll
                for (int bj = 0; bj < 2; ++bj)
#pragma unroll
                    for (int n = 0; n < 2; ++n) st8(rp + bj * HALF + n * 16, pk4(acc[ai][bj][m][n])); }
        return false; } };
struct EpiBf16Probe { bf16_t* O; int ldc;
    template <int NAI> __device__ __forceinline__ bool run(f32x4 (&acc)[2][2][4][2], const Unit& u, int wr, int wc, int fr, int fq) const {
        const int row0 = u.pm * BM + wr * 64 + fr, col0 = (u.pn & 7) * BM + wc * 32 + 4 * fq;
#pragma unroll
        for (int ai = 0; ai < 2; ++ai)
#pragma unroll
            for (int m = 0; m < 4; ++m) { bf16_t* rp = O + (size_t)(row0 + ai * HALF + m * 16) * ldc + col0;
#pragma unroll
                for (int bj = 0; bj < 2; ++bj)
#pragma unroll
                    for (int n = 0; n < 2; ++n) st8(rp + bj * HALF + n * 16, pk4(acc[ai][bj][m][n])); }
        return false; } };
struct EpiSwiGLU { bf16_t* O;
    template <int NAI> __device__ __forceinline__ bool run(f32x4 (&acc)[2][2][4][2], const Unit& u, int wr, int wc, int fr, int fq) const {
        const int row0 = u.pm * BM + wr * 64 + fr;
#pragma unroll
        for (int ai = 0; ai < 2; ++ai)
#pragma unroll
            for (int m = 0; m < 4; ++m) { bf16_t* rp = O + (size_t)(row0 + ai * HALF + m * 16) * DFF;
#pragma unroll
                for (int bj = 0; bj < 2; ++bj) { const int oc = 16 * (8 * u.pn + 4 * bj + wc) + 4 * fq; const f32x4 gg = acc[ai][bj][m][0], uu = acc[ai][bj][m][1]; f32x4 o;
#pragma unroll
                    for (int i = 0; i < 4; ++i) { const float e = __builtin_amdgcn_exp2f(-gg[i] * LOG2E); o[i] = gg[i] * fast_rcp(1.f + e) * uu[i]; }
                    st8(rp + oc, pk4(o)); } }
        return false; } };
struct EpiBranch { const bf16_t* G; bf16_t* O;
    template <int NAI> __device__ __forceinline__ bool run(f32x4 (&acc)[NAI][2][4][2], const Unit& u, int wr, int wc, int fr, int fq) const {
        const int tag = u.tag; if (tag == 2) return true;
        const int row0 = u.pm * (HALF * NAI) + wr * 64 + fr, col0 = u.pn * BM + wc * 32 + 4 * fq;
#pragma unroll
        for (int ai = 0; ai < NAI; ++ai)
#pragma unroll
            for (int m = 0; m < 4; ++m) { const size_t row = (size_t)(row0 + ai * HALF + m * 16); const bf16_t* gp = G + row * 3072 + col0;
#pragma unroll
                for (int bj = 0; bj < 2; ++bj)
#pragma unroll
                    for (int n = 0; n < 2; ++n) { const int co = bj * HALF + n * 16;
                        if (tag == 3) { const f32x4 gc = ld_bf4(gp + 2048 + co); st8(O + row * DM + col0 + co, pk4(acc[ai][bj][m][n] * gc)); }
                        else { const f32x4 g0 = ld_bf4(gp + tag * 1024 + co), g1 = ld_bf4(gp + (tag + 1) * 1024 + co); f32x4 r;
#pragma unroll
                            for (int i = 0; i < 4; ++i) r[i] = g0[i] * fast_rcp(g1[i]);
                            acc[ai][bj][m][n] = acc[ai][bj][m][n] * r; } } }
        return tag != 3; } };
typedef GAS unsigned gu32_t;
struct EpiRow { GAS unsigned char* ws; GAS float* out; const float* x0; const float* x1; const float* npre; const float* npost; LAS unsigned char* lds; int l, which;
    template <int NAI> __device__ __forceinline__ bool run(f32x4 (&acc)[NAI][2][4][2], const Unit& u, int wr, int wc, int fr, int fq) const {
        static_assert(NAI == 1, "fused row epilogue: 128-row tiles only");
        const int lane = fq * 16 + fr, wid = wr * 4 + wc, tid = wid * 64 + lane;
        unsigned char* const wsg = (unsigned char*)ws; float* const X = (float*)out;
        const float* mod = (const float*)(wsg + WS_MOD); bf16_t* const H = (bf16_t*)(wsg + WS_H);
        LAS float* P = (LAS float*)(lds + EXCH_OFF); LAS float* S = P + 512;
        const int pm = u.pm, pn = u.pn, row0 = pm * 128; const int ci = row0 < NCTX ? 0 : 1 + ((row0 - NCTX) >> 10);
        int lh = l, wh = 1; if (which == 2) { lh = l + 1; wh = 0; }
        const bool has_h = lh < DEPTH; const int lhc = has_h ? lh : 0;
        gu32_t* cnt0 = (gu32_t*)(ws + WS_CTL) + CW_XCNT + ((l * 2 + (which - 1)) * 2) * 1024 + pm * 16;
        GAS float* slots = (GAS float*)(ws + WS_XS);
        const int colw = pn * 256 + wc * 32 + 4 * fq;
        auto stats = [&](int e) {
#pragma unroll
            for (int m = 0; m < 4; ++m) { float sq = 0.f;
#pragma unroll
                for (int bj = 0; bj < 2; ++bj)
#pragma unroll
                    for (int n = 0; n < 2; ++n) { const f32x4 v = acc[0][bj][m][n]; sq += (v[0] * v[0] + v[1] * v[1]) + (v[2] * v[2] + v[3] * v[3]); }
                sq += shx(sq, 16, lane); sq += shx(sq, 32, lane);
                if (fq == 0) P[(wr * 64 + m * 16 + fr) * 4 + wc] = sq; }
            asm volatile("s_waitcnt lgkmcnt(0)" ::: "memory"); __builtin_amdgcn_s_barrier(); asm volatile("" ::: "memory");
            if (tid < 128) { const float t = (P[tid * 4 + 0] + P[tid * 4 + 1]) + (P[tid * 4 + 2] + P[tid * 4 + 3]);
                __hip_atomic_store(slots + ((size_t)e * NTOK + row0 + tid) * 4 + pn, t, __ATOMIC_RELAXED, __HIP_MEMORY_SCOPE_AGENT); }
            asm volatile("s_waitcnt vmcnt(0)" ::: "memory");
            if (tid < 128 && lane == 0) __hip_atomic_fetch_add(cnt0 + e * 1024, 1u, __ATOMIC_RELAXED, __HIP_MEMORY_SCOPE_AGENT);
            if (wid == 0) {
                for (int sp = 0; sp < 400000; ++sp) { if ((unsigned)__builtin_amdgcn_readfirstlane(__hip_atomic_load(cnt0 + e * 1024, __ATOMIC_RELAXED, __HIP_MEMORY_SCOPE_AGENT)) >= 8u) break; __builtin_amdgcn_s_sleep(2); }
                asm volatile("" ::: "memory");
            }
            asm volatile("s_waitcnt vmcnt(0) lgkmcnt(0)" ::: "memory"); __builtin_amdgcn_s_barrier(); asm volatile("" ::: "memory");
            if (tid < 128) { const GAS float* sp4 = slots + ((size_t)e * NTOK + row0 + tid) * 4; float tot = 0.f;
#pragma unroll
                for (int t = 0; t < 4; ++t) tot += __hip_atomic_load(sp4 + t, __ATOMIC_RELAXED, __HIP_MEMORY_SCOPE_AGENT);
                S[tid] = 1.0f / sqrtf(tot * (1.0f / DM) + NORM_EPS); }
            asm volatile("s_waitcnt lgkmcnt(0)" ::: "memory"); __builtin_amdgcn_s_barrier(); asm volatile("" ::: "memory");
        };
        {
            f32x4 xv[4][2][2];
#pragma unroll
            for (int m = 0; m < 4; ++m) { const int row = row0 + wr * 64 + m * 16 + fr;
                const float* xs = (l == 0 && which == 1) ? (row < NCTX ? x0 + (size_t)row * DM : x1 + (size_t)(row - NCTX) * DM) : X + (size_t)row * DM;
#pragma unroll
                for (int bj = 0; bj < 2; ++bj)
#pragma unroll
                    for (int n = 0; n < 2; ++n) xv[m][bj][n] = *(const f32x4*)(xs + colw + 128 * bj + 16 * n); }
            const float* gate = mod + (size_t)(l * 5 + ci) * 6144 + (which == 1 ? 2048 : 5120); const float* gpo = npost + (size_t)(l * 2 + (which - 1)) * DM;
            f32x4 gg[2][2];
#pragma unroll
            for (int bj = 0; bj < 2; ++bj)
#pragma unroll
                for (int n = 0; n < 2; ++n) { const int c0 = colw + 128 * bj + 16 * n; gg[bj][n] = *(const f32x4*)(gpo + c0) * *(const f32x4*)(gate + c0); }
            stats(0);
#pragma unroll
            for (int bj = 0; bj < 2; ++bj)
#pragma unroll
                for (int n = 0; n < 2; ++n) { const int c0 = colw + 128 * bj + 16 * n;
#pragma unroll
                    for (int m = 0; m < 4; ++m) { const int rl = wr * 64 + m * 16 + fr; const float rstd = S[rl];
                        const f32x4 xn = xv[m][bj][n] + gg[bj][n] * (acc[0][bj][m][n] * rstd); acc[0][bj][m][n] = xn; *(GAS f32x4*)(X + (size_t)(row0 + rl) * DM + c0) = xn; } }
        }
        if (has_h) {
            const float* gpr = npre + (size_t)(lhc * 2 + wh) * DM; const float* mm = mod + (size_t)(lhc * 5 + ci) * 6144 + (wh ? 3072 : 0);
            f32x4 gs[2][2], sh[2][2];
#pragma unroll
            for (int bj = 0; bj < 2; ++bj)
#pragma unroll
                for (int n = 0; n < 2; ++n) { const int c0 = colw + 128 * bj + 16 * n; gs[bj][n] = *(const f32x4*)(gpr + c0) * (1.0f + *(const f32x4*)(mm + 1024 + c0)); sh[bj][n] = *(const f32x4*)(mm + c0); }
            stats(1);
#pragma unroll
            for (int bj = 0; bj < 2; ++bj)
#pragma unroll
                for (int n = 0; n < 2; ++n) { const int c0 = colw + 128 * bj + 16 * n;
#pragma unroll
                    for (int m = 0; m < 4; ++m) { const int rl = wr * 64 + m * 16 + fr; const float rstd = S[rl];
                        st8(H + (size_t)(row0 + rl) * DM + c0, pk4((acc[0][bj][m][n] * rstd) * gs[bj][n] + sh[bj][n])); } }
        }
        return false; } };
struct EpiIn { GAS unsigned char* ws; GAS float* out; int layer;
    __device__ __forceinline__ void tstore(f32x4 (&acc)[2][2][4][2], int bj, bf16_t* buf, int RB, int cvb, float* fo, int fld, int pm, int wr, int wc, int fr, int fq) const {
        const bool lat = pm >= 16; const int T = lat ? 1024 : 256;
#pragma unroll
        for (int n = 0; n < 2; ++n) { const int cv = cvb + 32 * wc + 16 * n + 4 * fq;
#pragma unroll
            for (int ai = 0; ai < 2; ++ai)
#pragma unroll
                for (int m = 0; m < 4; ++m) { int tok = pm * 256 + ai * 128 + wr * 64 + m * 16 + fr; asm volatile("" : "+v"(tok)); const f32x4 v = acc[ai][bj][m][n];
                    int bb, t; if (lat) { bb = (tok - NCTX) >> 10; t = (tok - NCTX) & 1023; } else { bb = tok >> 8; t = tok & 255; }
                    bf16_t* p = buf + (unsigned)((lat ? RB * 4096 : 0) + (bb * RB + cv) * T + t);
#pragma unroll
                    for (int i = 0; i < 4; ++i) st2(p + i * T, f2bf(v[i]));
                    if (!lat && fo) __builtin_nontemporal_store(v, (GAS f32x4*)(fo + (unsigned)(((bb * 2 + layer) * 256 + t) * fld + cv))); } } }
    __device__ __forceinline__ void nstore(f32x4 (&acc)[2][2][4][2], int bj, bf16_t* buf, int ld, int cb, float sc, float* fo, int pm, int wr, int wc, int fr, int fq) const {
        const bool lat = pm >= 16;
#pragma unroll
        for (int n = 0; n < 2; ++n) { const int col = cb + 32 * wc + 16 * n + 4 * fq;
#pragma unroll
            for (int ai = 0; ai < 2; ++ai)
#pragma unroll
                for (int m = 0; m < 4; ++m) { int tok = pm * 256 + ai * 128 + wr * 64 + m * 16 + fr; asm volatile("" : "+v"(tok)); const f32x4 v = acc[ai][bj][m][n];
                    st8(buf + (unsigned)(tok * ld + col), pk4(v * sc));
                    if (!lat && fo) { const int bb = tok >> 8, t = tok & 255; __builtin_nontemporal_store(v, (GAS f32x4*)(fo + (unsigned)(((bb * 2 + layer) * 256 + t) * ld + col))); } } } }
    template <int NAI> __device__ __forceinline__ bool run(f32x4 (&acc)[2][2][4][2], const Unit& u, int wr, int wc, int fr, int fq) const {
        unsigned char* const wsg = (unsigned char*)ws; float* const outg = (float*)out;
        bf16_t* const Qa = (bf16_t*)(wsg + WS_QA); bf16_t* const Ka = (bf16_t*)(wsg + WS_KA); bf16_t* const VaT = (bf16_t*)(wsg + WS_VAT); bf16_t* const Qb = (bf16_t*)(wsg + WS_QB);
        bf16_t* const Kb = (bf16_t*)(wsg + WS_KB); bf16_t* const VbT = (bf16_t*)(wsg + WS_VBT); bf16_t* const UT = (bf16_t*)(wsg + WS_UT); bf16_t* const G = (bf16_t*)(wsg + WS_G);
        const float* const ropec = (const float*)(wsg + WS_ROPEC); const float* const ropes = (const float*)(wsg + WS_ROPES);
        const int pm = u.pm; const bool lat = pm >= 16;
#pragma unroll
        for (int bj = 0; bj < 2; ++bj) {
            const int cb = u.pn * 256 + bj * 128;
            if (cb < 640) {
                const bool isq = cb < 512; const int head = ((isq ? cb : cb - 512) >> 6) + (wc >> 1); const int dlo = 16 * (wc & 1) + 4 * fq;
#pragma unroll
                for (int ai = 0; ai < 2; ++ai)
#pragma unroll
                    for (int m = 0; m < 4; ++m) { int tok = pm * 256 + ai * 128 + wr * 64 + m * 16 + fr; asm volatile("" : "+v"(tok)); const f32x4 v0 = acc[ai][bj][m][0], v1 = acc[ai][bj][m][1]; f32x4 o0 = v0, o1 = v1;
                        if (lat) { const int t = (tok - NCTX) & 1023; const f32x4 c = *(const f32x4*)(ropec + t * 32 + dlo), s = *(const f32x4*)(ropes + t * 32 + dlo); o0 = v0 * c - v1 * s; o1 = v0 * s + v1 * c; }
                        if (isq) { bf16_t* p = Qa + (unsigned)(tok * 512 + head * 64 + dlo); st8(p, pk4(o0 * QSCALE)); st8(p + 32, pk4(o1 * QSCALE)); }
                        else { bf16_t* p = Ka + (unsigned)(tok * 128 + head * 64 + dlo); st8(p, pk4(o0)); st8(p + 32, pk4(o1));
                            if (!lat) { const int bb = tok >> 8, t = tok & 255; float* fo = outg + (unsigned)(OUT_NAK + ((bb * 2 + layer) * 256 + t) * 128 + head * 64 + dlo); __builtin_nontemporal_store(o0, (GAS f32x4*)fo); __builtin_nontemporal_store(o1, (GAS f32x4*)(fo + 32)); } } }
            }
            else if (cb < 768)  tstore(acc, bj, VaT, 128, cb - 640, outg + OUT_NAV, 128, pm, wr, wc, fr, fq);
            else if (cb < 1280) nstore(acc, bj, Qb, 512, cb - 768, QSCALE, nullptr, pm, wr, wc, fr, fq);
            else if (cb < 1792) nstore(acc, bj, Kb, 512, cb - 1280, 1.f, outg + OUT_NBK, pm, wr, wc, fr, fq);
            else if (cb < 2304) tstore(acc, bj, VbT, 512, cb - 1792, outg + OUT_NBV, 512, pm, wr, wc, fr, fq);
            else if (cb < 2816) tstore(acc, bj, UT, 512, cb - 2304, nullptr, 0, pm, wr, wc, fr, fq);
            else {
#pragma unroll
                for (int n = 0; n < 2; ++n) { const int col = cb - 2816 + 32 * wc + 16 * n + 4 * fq;
#pragma unroll
                    for (int ai = 0; ai < 2; ++ai)
#pragma unroll
                        for (int m = 0; m < 4; ++m) { int tok = pm * 256 + ai * 128 + wr * 64 + m * 16 + fr; asm volatile("" : "+v"(tok)); const f32x4 v = acc[ai][bj][m][n]; f32x4 o;
#pragma unroll
                            for (int i = 0; i < 4; ++i) o[i] = sigmoidf_(v[i]);
                            st8(G + (unsigned)(tok * 3072 + col), pk4(o)); } }
            }
        }
        return false; } };
}

typedef GAS unsigned gu32;
#define RLX_AGENT __ATOMIC_RELAXED, __HIP_MEMORY_SCOPE_AGENT
#define XB_TMO      128
#define XB_XCNT(j)  (256  + 64 * (j))
#define XB_XSUB(j)  (1280 + 64 * (j))
#define XB_XGEN(j)  (2304 + 64 * (j))
#define XB_TOP      3328
#define XB_TOPGEN   3392
#define XCD_BAR_WORDS 3456
#define XB_LSUB(j)  (3520 + 64 * (j))
#define XB_LGEN(j)  (4096 + 64 * (j))
#define XB_SPIN_CAP (1u << 18)
__device__ __forceinline__ unsigned xb_ld(unsigned* p)              { return __hip_atomic_load(p, __ATOMIC_RELAXED, __HIP_MEMORY_SCOPE_AGENT); }
__device__ __forceinline__ unsigned xb_add(unsigned* p, unsigned v) { return __hip_atomic_fetch_add(p, v, __ATOMIC_RELAXED, __HIP_MEMORY_SCOPE_AGENT); }
__device__ __forceinline__ unsigned xb_xcc_id() { return (unsigned)__builtin_amdgcn_s_getreg((3 << 11) | 20) & 0xFu; }
#define XB_SPIN(cond, bar) do { unsigned _sp = 0; while (cond) { __builtin_amdgcn_s_sleep(1); \
    if ((++_sp & 255u) == 0u) { if (xb_ld(&(bar)[XB_TMO])) break; if (_sp > XB_SPIN_CAP) { atomicAdd(&(bar)[XB_TMO], 1u); break; } } } } while (0)
struct XcdBarrier { unsigned* bar; unsigned x; volatile LAS unsigned* st; };
__device__ __forceinline__ XcdBarrier xcd_barrier_post(unsigned* bar, volatile LAS unsigned* st) {
    XcdBarrier b; b.bar = bar; b.x = xb_xcc_id(); b.st = st;
    if (threadIdx.x == 0) { const unsigned r = xb_add(&bar[XB_XCNT(b.x)], 1u); st[3] = r; st[4] = b.x; }
    return b;
}
__device__ __forceinline__ void xcd_barrier_complete(unsigned* bar, unsigned x, unsigned& nloc, unsigned& nx, unsigned& uni) {
    const unsigned G = gridDim.x * gridDim.y * gridDim.z;
    unsigned sum, cnt, mine, ok, sp = 0u;
    for (;;) {
        sum = 0u; cnt = 0u; mine = 0u; ok = 1u;
#pragma unroll
        for (unsigned j = 0; j < 16; ++j) { const unsigned c = xb_ld(&bar[XB_XCNT(j)]); sum += c; cnt += (c > 0u) ? 1u : 0u; mine = (j == x) ? c : mine; ok &= (c == (j < 8u ? 32u : 0u)) ? 1u : 0u; }
        if (sum == G) break;
        __builtin_amdgcn_s_sleep(1);
        if ((++sp & 255u) == 0u) { if (xb_ld(&bar[XB_TMO])) break; if (sp > XB_SPIN_CAP) { atomicAdd(&bar[XB_TMO], 1u); break; } }
    }
    nloc = mine > 0u ? mine : 1u; nx = cnt > 0u ? cnt : 1u; uni = (ok != 0u && sum == G && G == 256u) ? 1u : 0u;
}
__device__ __forceinline__ void xcd_barrier(const XcdBarrier& b) {
    asm volatile("s_waitcnt vmcnt(0)" ::: "memory");
    __syncthreads();
    if (threadIdx.x == 0) {
        unsigned* bar = b.bar; asm volatile("" : "+s"(bar));
        __builtin_amdgcn_s_waitcnt(0);
        asm volatile("buffer_inv sc1" ::: "memory");
        unsigned nloc = b.st[0], nx = b.st[1];
        if (nloc == 0u) { unsigned uni; xcd_barrier_complete(bar, b.x, nloc, nx, uni); b.st[0] = nloc; b.st[1] = nx; b.st[2] = uni; }
        const unsigned old = xb_add(&bar[XB_XSUB(b.x)], 1u);
        const unsigned gen = old / nloc;
        if (old + 1u == (gen + 1u) * nloc) {
            __builtin_amdgcn_fence(__ATOMIC_RELEASE, "agent");
            asm volatile("s_waitcnt vmcnt(0)" ::: "memory");
            const unsigned og = xb_add(&bar[XB_TOP], 1u);
            const unsigned tg = og / nx;
            if (og + 1u == (tg + 1u) * nx) xb_add(&bar[XB_TOPGEN], 1u);
            else XB_SPIN(xb_ld(&bar[XB_TOPGEN]) == tg, bar);
            xb_add(&bar[XB_XGEN(b.x)], 1u);
            asm volatile("s_waitcnt vmcnt(0)" ::: "memory");
        } else {
            XB_SPIN(xb_ld(&bar[XB_XGEN(b.x)]) == gen, bar);
            asm volatile("s_waitcnt vmcnt(0)" ::: "memory");
        }
    }
    __syncthreads();
}

__device__ __forceinline__ void xcd_local_barrier(const XcdBarrier& b) {
    asm volatile("s_waitcnt vmcnt(0)" ::: "memory");
    __syncthreads();
    if (threadIdx.x == 0) {
        unsigned* bar = b.bar; asm volatile("" : "+s"(bar));
        const unsigned x = b.st[4];
        __builtin_amdgcn_s_waitcnt(0);
        asm volatile("buffer_inv sc1" ::: "memory");
        const unsigned old = xb_add(&bar[XB_LSUB(x)], 1u), gen = old >> 5;
        if ((old & 31u) == 31u) (void)xb_add(&bar[XB_LGEN(x)], 1u);
        else XB_SPIN(xb_ld(&bar[XB_LGEN(x)]) == gen, bar);
        asm volatile("s_waitcnt vmcnt(0)" ::: "memory");
    }
    __syncthreads();
}

struct Args { const float* in[19]; float* out; unsigned char* ws; int ph_lo, ph_hi; };
struct Frame {
    LAS unsigned char* lds; int vcu, G, lm;
    GAS float* out; GAS unsigned char* ws;
};
typedef const __attribute__((address_space(4))) Args* ArgsP;
#define INP(k) ((const float*)(const GAS float*)(args->in[k]))
#define WSP(T, off) ((T*)(GAS T*)(F.ws + (off)))

__device__ __forceinline__ int rowmap(int mode, int n) {
    if (mode == 1) { if (n < 640) { const int d = n & 63; return (n & ~63) + 32 * ((d & 31) >> 4) + 16 * (d >> 5) + (d & 15); } return n; }
    if (mode == 2) { const int nn = n >= DFF ? 1 : 0, jj = n - nn * DFF; return 32 * (jj >> 4) + 16 * nn + (jj & 15); }
    return n;
}
__device__ __forceinline__ void p0_transpose_item(const float* W, int K, int N, bf16_t* WT, int mode, int item, int lane) {
    const int nblk = N >> 6, kb = item / nblk, nb = item - kb * nblk, g = lane >> 4, c = lane & 15;
    const float* src = W + (size_t)(kb * 32 + 8 * g) * N + nb * 64 + 4 * c;
    f32x4 v[8];
#pragma unroll
    for (int j = 0; j < 8; ++j) v[j] = __builtin_nontemporal_load((const f32x4*)(src + (size_t)j * N));
    bf16_t* dst = WT + kb * 32 + 8 * g;
#pragma unroll
    for (int e = 0; e < 4; ++e) { u32x4 o; o.x = pk2(v[0][e], v[1][e]); o.y = pk2(v[2][e], v[3][e]); o.z = pk2(v[4][e], v[5][e]); o.w = pk2(v[6][e], v[7][e]);
        st16u(dst + (size_t)rowmap(mode, nb * 64 + 4 * c + e) * K, o); }
}
struct TItem { const float* W; bf16_t* WT; int K, N, mode, kb, nb; };
__device__ __forceinline__ void titem_load(const TItem& t, f32x4 (&v)[8], int lane) {
    const float* src = t.W + (size_t)(t.kb * 32 + 8 * (lane >> 4)) * t.N + t.nb * 64 + 4 * (lane & 15);
#pragma unroll
    for (int j = 0; j < 8; ++j) v[j] = __builtin_nontemporal_load((const f32x4*)(src + (size_t)j * t.N));
}
__device__ __forceinline__ void titem_store(const TItem& t, const f32x4 (&v)[8], int lane) {
    bf16_t* dst = t.WT + t.kb * 32 + 8 * (lane >> 4);
#pragma unroll
    for (int e = 0; e < 4; ++e) { u32x4 o; o.x = pk2(v[0][e], v[1][e]); o.y = pk2(v[2][e], v[3][e]); o.z = pk2(v[4][e], v[5][e]); o.w = pk2(v[6][e], v[7][e]);
        *(u32x4*)(dst + (size_t)rowmap(t.mode, t.nb * 64 + 4 * (lane & 15) + e) * t.K) = o; }
}
__device__ __forceinline__ void p0_fold_item(const float* Wc, bf16_t* WtBr, int item, int lane) {
    const int ct = item & 3, nt = (item >> 2) & 31, g = (item >> 7) & 3, cs = item >> 9;
    const int r = lane & 31, hh = lane >> 5, c = ct * 32 + r;
    const float* ap = Wc + (size_t)(g * 128 + hh) * DM + nt * 32 + r;
    f32x16 acc;
#pragma unroll
    for (int i = 0; i < 16; ++i) acc[i] = 0.f;
#pragma unroll 8
    for (int st = 0; st < 64; ++st) {
        const float a = ap[(size_t)(2 * st) * DM];
        float sv, cv; sincospif((float)(((2 * st + hh) * c) & 127) * (1.0f / 64.0f), &sv, &cv);
        const float bq = (cs ? -sv : cv) * 0.08838834764831845f;
        acc = __builtin_amdgcn_mfma_f32_32x32x2f32(a, bq, acc, 0, 0, 0);
    }
    bf16_t* o = WtBr + (size_t)(2 + cs) * DM * 512 + g * 128 + c;
#pragma unroll
    for (int i = 0; i < 16; ++i) st2(o + (size_t)(nt * 32 + (i & 3) + 8 * (i >> 2) + 4 * hh) * 512, f2bf(acc[i]));
}
__device__ __forceinline__ void p0_prologue(Frame& F, ArgsP args) {
    asm volatile("" : "+s"(args));
    const int tid = opaque_tid(), lane = tid & 63, wave = __builtin_amdgcn_readfirstlane(tid >> 6);
    const int gw = F.vcu * NWAVES + wave, NGW = F.G * NWAVES;
#if PREREAD
    {
        const int szs[6] = {2 * DM * 6144, 2 * DM * DIN, 2 * 3 * 512 * DM, 2 * DM * DM, 2 * DM * DFF2, 2 * DFF * DM};
        const int idx[6] = {8, 12, 15, 16, 17, 18};
        float accs = 0.f;
#pragma unroll
        for (int a = 0; a < 6; ++a) { const f32x4* src = (const f32x4*)(a == 0 ? INP(8) : a == 1 ? INP(12) : a == 2 ? INP(15) : a == 3 ? INP(16) : a == 4 ? INP(17) : INP(18)); const int n4 = szs[a] / 4;
            for (int i = gw * 256 + lane; i < n4; i += NGW * 256) { f32x4 t0 = src[i], t1 = i + 64 < n4 ? src[i + 64] : t0, t2 = i + 128 < n4 ? src[i + 128] : t0, t3 = i + 192 < n4 ? src[i + 192] : t0; accs += t0[0] + t1[1] + t2[2] + t3[3]; } }
        if (accs == 123.456f) WSP(float, WS_MOD)[0] = accs;
    }
#endif
    {
        LAS float* sc = (LAS float*)F.lds;
        LAS float* part = (LAS float*)(F.lds + 32768);
        for (int i = tid; i < 5 * 1024; i += NWAVES * 64) { const int ci = i >> 10, k = i & 1023; const float v = ci == 0 ? INP(7)[k] : INP(6)[(ci - 1) * 1024 + k]; sc[i] = v * sigmoidf_(v); }
        __syncthreads();
        for (int item = F.vcu; item < 192; item += F.G) {
            const int l = item / 96, j0 = (item % 96) * 64; const int kb = wave * 128; const float* W = INP(8) + (size_t)l * DM * 6144 + (size_t)kb * 6144 + j0 + lane;
            float a[5] = {0.f, 0.f, 0.f, 0.f, 0.f};
            for (int k0 = 0; k0 < 128; k0 += 32) { float w[32];
#pragma unroll
                for (int u = 0; u < 32; ++u) w[u] = __builtin_nontemporal_load(W + (size_t)(k0 + u) * 6144);
#pragma unroll
                for (int u = 0; u < 32; ++u)
#pragma unroll
                    for (int ci = 0; ci < 5; ++ci) a[ci] += sc[ci * 1024 + kb + k0 + u] * w[u]; }
#pragma unroll
            for (int ci = 0; ci < 5; ++ci) part[(wave * 5 + ci) * 64 + lane] = a[ci];
            __syncthreads();
            if (wave < 5) { float sm = 0.f;
#pragma unroll
                for (int w = 0; w < 8; ++w) sm += part[(w * 5 + wave) * 64 + lane];
                __hip_atomic_store((GAS float*)(WSP(float, WS_MOD) + (size_t)(l * 5 + wave) * 6144 + j0 + lane), sm + INP(9)[l * 6144 + j0 + lane], __ATOMIC_RELAXED, __HIP_MEMORY_SCOPE_AGENT); }
            asm volatile("s_waitcnt vmcnt(0)" ::: "memory");
            __syncthreads();
            if (tid == 0) __hip_atomic_fetch_add((GAS unsigned*)(F.ws + WS_CTL) + CW_MODCNT, 1u, __ATOMIC_RELAXED, __HIP_MEMORY_SCOPE_AGENT);
        }
    }
    {
        constexpr int I_IN = 32 * (DIN / 64), I_BR = 16 * 16, I_OUT = 32 * 16, I_F1 = 32 * (DFF2 / 64), I_F2 = (DFF / 32) * 16;
        constexpr int NIT = I_IN + 2 * I_BR + I_OUT + I_F1 + I_F2;
        auto decode = [&](int it) -> TItem {
            const int l = it >= NIT ? 1 : 0; int r = it - l * NIT; unsigned char* wl = (unsigned char*)F.ws + WS_W + (size_t)l * W_LAYER; TItem t;
            if (r < I_IN) { t.W = INP(12) + (size_t)l * DM * DIN; t.K = DM; t.N = DIN; t.WT = (bf16_t*)(wl + W_IN); t.mode = 1; }
            else if ((r -= I_IN) < I_BR) { t.W = INP(15) + (size_t)(l * 3 + 0) * 512 * DM; t.K = 512; t.N = DM; t.WT = (bf16_t*)(wl + W_BR); t.mode = 0; }
            else if ((r -= I_BR) < I_BR) { t.W = INP(15) + (size_t)(l * 3 + 1) * 512 * DM; t.K = 512; t.N = DM; t.WT = (bf16_t*)(wl + W_BR) + (size_t)DM * 512; t.mode = 0; }
            else if ((r -= I_BR) < I_OUT) { t.W = INP(16) + (size_t)l * DM * DM; t.K = DM; t.N = DM; t.WT = (bf16_t*)(wl + W_OUT); t.mode = 0; }
            else if ((r -= I_OUT) < I_F1) { t.W = INP(17) + (size_t)l * DM * DFF2; t.K = DM; t.N = DFF2; t.WT = (bf16_t*)(wl + W_F1); t.mode = 2; }
            else { r -= I_F1; t.W = INP(18) + (size_t)l * DFF * DM; t.K = DFF; t.N = DM; t.WT = (bf16_t*)(wl + W_F2); t.mode = 0; }
            const int nblk = t.N >> 6; t.kb = r / nblk; t.nb = r - t.kb * nblk; return t; };
        for (int it = gw; it < 2 * NIT; it += 2 * NGW) {
            const bool two = it + NGW < 2 * NIT; const TItem ta = decode(it), tb = decode(two ? it + NGW : it);
            f32x4 va[8], vb[8];
            titem_load(ta, va, lane); if (two) titem_load(tb, vb, lane);
            titem_store(ta, va, lane); if (two) titem_store(tb, vb, lane);
        }
        for (int it = gw; it < 2048; it += NGW) { const int l = it >> 10; p0_fold_item(INP(15) + (size_t)(l * 3 + 2) * 512 * DM, (bf16_t*)((unsigned char*)F.ws + WS_W + (size_t)l * W_LAYER + W_BR), it & 1023, lane); }
    }
    for (int it = gw; it < 128 + 512; it += NGW) {
        if (it < 128) { const int bl = it >> 4; p0_transpose_item(INP(3) + (size_t)bl * 256 * 128, 256, 128, WSP(bf16_t, WS_CVAT) + (size_t)bl * 128 * 256, 0, it & 15, lane); }
        else { const int r = it - 128, bl = r >> 6; p0_transpose_item(INP(5) + (size_t)bl * 256 * 512, 256, 512, WSP(bf16_t, WS_CVBT) + (size_t)bl * 512 * 256, 0, r & 63, lane); }
    }
    {
        const int gt = gw * 64 + lane, NT = NGW * 64;
        GAS bf16_t* dc = (GAS bf16_t*)WSP(bf16_t, WS_DFTC); GAS bf16_t* dl = (GAS bf16_t*)WSP(bf16_t, WS_DFTL);
        for (int i = gt; i < 65536; i += NT) { const int a = i >> 8, b = i & 255; float sv, cv; sincospif((float)((a * b) & 255) * (1.0f / 128.0f), &sv, &cv); dc[i] = (bf16_t)f2bf(cv * 0.0625f); dc[65536 + i] = (bf16_t)f2bf(sv * 0.0625f); }
        for (int i = gt; i < 1048576; i += NT) { const int a = i >> 10, b = i & 1023; float sv, cv; sincospif((float)((a * b) & 1023) * (1.0f / 512.0f), &sv, &cv); dl[i] = (bf16_t)f2bf(cv * 0.03125f); dl[1048576 + i] = (bf16_t)f2bf(sv * 0.03125f); }
        GAS float* rc = (GAS float*)WSP(float, WS_ROPEC); GAS float* rs = (GAS float*)WSP(float, WS_ROPES);
        for (int i = gt; i < 32768; i += NT) { const int t = i >> 5, p = i & 31; const float pos = (float)(p < 16 ? (t >> 6) : (t & 63)); const float inv = powf(10000.0f, -(float)(p & 15) * (1.0f / 16.0f));
            const float ang = pos * inv; rc[i] = cosf(ang); rs[i] = sinf(ang); }
        const f32x4* cak = (const f32x4*)INP(2); const f32x4* cbk = (const f32x4*)INP(4);
        GAS u32x2* CKa = (GAS u32x2*)WSP(u32x2, WS_CKA); GAS u32x2* CKb = (GAS u32x2*)WSP(u32x2, WS_CKB);
        for (int i = gt; i < 65536; i += NT) CKa[i] = pk4(cak[i]);
        for (int i = gt; i < 262144; i += NT) CKb[i] = pk4(cbk[i]);
    }
    if (wave == 0) {
        for (int sp = 0; sp < 400000; ++sp) { if ((unsigned)__builtin_amdgcn_readfirstlane(__hip_atomic_load((GAS unsigned*)(F.ws + WS_CTL) + CW_MODCNT, __ATOMIC_RELAXED, __HIP_MEMORY_SCOPE_AGENT)) >= 192u) break; __builtin_amdgcn_s_sleep(2); }
        __builtin_amdgcn_fence(__ATOMIC_ACQUIRE, "agent");
    }
    asm volatile("s_waitcnt vmcnt(0) lgkmcnt(0)" ::: "memory"); __syncthreads();
}

__device__ __forceinline__ void row_phase(Frame& F, ArgsP args, int l, int which) {
    asm volatile("" : "+s"(args));
    const int tid = opaque_tid(), lane = tid & 63, wave = __builtin_amdgcn_readfirstlane(tid >> 6);
    const int gw = F.vcu * NWAVES + wave, NGW = F.G * NWAVES;
    const float* mod = WSP(float, WS_MOD); const bf16_t* Y = WSP(bf16_t, WS_Y); bf16_t* H = WSP(bf16_t, WS_H); float* const outp = (float*)F.out;
    int lh = l, wh = 0;
    if (which == 1) wh = 1; else if (which == 2) { lh = l + 1; wh = 0; }
    const bool has_h = lh < DEPTH; const int lhc = has_h ? lh : 0;
    f32x4 gpo[4], gpr[4];
    { const float* gp = INP(11) + (size_t)(l * 2 + (which == 0 ? 0 : which - 1)) * DM; const float* gq = INP(10) + (size_t)(lhc * 2 + wh) * DM;
#pragma unroll
      for (int j = 0; j < 4; ++j) { gpo[j] = *(const f32x4*)(gp + 256 * j + 4 * lane); gpr[j] = *(const f32x4*)(gq + 256 * j + 4 * lane); } }
    for (int m0 = gw; m0 < NTOK; m0 += 2 * NGW) {
        f32x4 x[2][4], gt[2][4], sh[2][4], sc[2][4]; u32x2 yb[2][4];
#pragma unroll
        for (int r = 0; r < 2; ++r) { const int m = m0 + r * NGW; const int ci = m < NCTX ? 0 : 1 + ((m - NCTX) >> 10);
            const float* xsrc = (which == 0 || (which == 1 && l == 0)) ? (m < NCTX ? INP(0) + (size_t)m * DM : INP(1) + (size_t)(m - NCTX) * DM) : outp + (size_t)m * DM;
            const float* gate = mod + (size_t)(l * 5 + ci) * 6144 + (which == 1 ? 2048 : 5120); const float* mm = mod + (size_t)(lhc * 5 + ci) * 6144 + (wh ? 3072 : 0);
#pragma unroll
            for (int j = 0; j < 4; ++j) { x[r][j] = *(const f32x4*)(xsrc + 256 * j + 4 * lane);
                if (which != 0) { yb[r][j] = *(const u32x2*)(Y + (size_t)m * DM + 256 * j + 4 * lane); gt[r][j] = *(const f32x4*)(gate + 256 * j + 4 * lane); }
                if (has_h) { sh[r][j] = *(const f32x4*)(mm + 256 * j + 4 * lane); sc[r][j] = *(const f32x4*)(mm + 1024 + 256 * j + 4 * lane); } } }
#pragma unroll
        for (int r = 0; r < 2; ++r) { const int m = m0 + r * NGW;
            if (which != 0) {
                f32x4 y[4]; float s = 0.f;
#pragma unroll
                for (int j = 0; j < 4; ++j) { const u32x2 w = yb[r][j]; y[j][0] = __builtin_bit_cast(float, w.x << 16); y[j][1] = __builtin_bit_cast(float, w.x & 0xffff0000u); y[j][2] = __builtin_bit_cast(float, w.y << 16); y[j][3] = __builtin_bit_cast(float, w.y & 0xffff0000u);
                    s += (y[j][0] * y[j][0] + y[j][1] * y[j][1]) + (y[j][2] * y[j][2] + y[j][3] * y[j][3]); }
                const float rstd = 1.0f / sqrtf(wave_sum(s, lane) * (1.0f / DM) + NORM_EPS);
#pragma unroll
                for (int j = 0; j < 4; ++j) { x[r][j] = x[r][j] + gt[r][j] * (y[j] * rstd * gpo[j]); st16f(outp + (size_t)m * DM + 256 * j + 4 * lane, x[r][j]); }
            }
            if (has_h) {
                float s = 0.f;
#pragma unroll
                for (int j = 0; j < 4; ++j) s += (x[r][j][0] * x[r][j][0] + x[r][j][1] * x[r][j][1]) + (x[r][j][2] * x[r][j][2] + x[r][j][3] * x[r][j][3]);
                const float rstd = 1.0f / sqrtf(wave_sum(s, lane) * (1.0f / DM) + NORM_EPS);
#pragma unroll
                for (int j = 0; j < 4; ++j) { const f32x4 h = (x[r][j] * rstd * gpr[j]) * (1.0f + sc[r][j]) + sh[r][j]; st8(H + (size_t)m * DM + 256 * j + 4 * lane, pk4(h)); }
            }
        }
    }
}

#define MFMA32(a, b, c) __builtin_amdgcn_mfma_f32_32x32x16_bf16((a), (b), (c), 0, 0, 0)
constexpr int ATT_KPITCH = 144;
constexpr int ATT_VT_OFF = 69120;
__device__ __forceinline__ int crow0(int r) { return (r & 3) + 8 * (r >> 2); }
template <int SEGLEN, int NU>
__device__ __forceinline__ void stage_k_issue(u32x4 (&v)[NU], const bf16_t* src, int nrows, int segstride, int ldk, int tid) {
#pragma unroll
    for (int u = 0; u < NU; ++u) { const int x = tid + NWAVES * 64 * u, r0 = x >> 3, r = r0 < nrows ? r0 : nrows - 1, c = x & 7, sg = r / SEGLEN, j = r - sg * SEGLEN;
        v[u] = *(const u32x4*)(src + (size_t)(sg * segstride + j) * ldk + c * 8); }
}
template <int NU>
__device__ __forceinline__ void stage_k_commit(const u32x4 (&v)[NU], LAS unsigned char* dst, int nrows, int tid) {
#pragma unroll
    for (int u = 0; u < NU; ++u) { const int x = tid + NWAVES * 64 * u, r = x >> 3, c = x & 7;
        if (r < nrows) *(LAS u32x4*)(dst + r * ATT_KPITCH + c * 16) = v[u]; }
}
template <int SEGLEN, int NU>
__device__ __forceinline__ void stage_vt_issue(u32x2 (&v)[2][NU], const bf16_t* src, int NK, int segstride, int T, int tid) {
    const int d0 = tid >> 4, sub = tid & 15;
#pragma unroll
    for (int ps = 0; ps < 2; ++ps)
#pragma unroll
        for (int u = 0; u < NU; ++u) { const int k0 = 4 * (sub + 16 * u), k = k0 < NK ? k0 : NK - 4, sg = k / SEGLEN, j = k - sg * SEGLEN;
            v[ps][u] = *(const u32x2*)(src + (size_t)(d0 + 32 * ps) * T + sg * segstride + j); }
}
template <int NU>
__device__ __forceinline__ void stage_vt_commit(const u32x2 (&v)[2][NU], LAS unsigned char* dst, int NK, int pitchB, int tid) {
    const int d0 = tid >> 4, sub = tid & 15;
#pragma unroll
    for (int ps = 0; ps < 2; ++ps)
#pragma unroll
        for (int u = 0; u < NU; ++u) { const int k = 4 * (sub + 16 * u);
            if (k < NK) *(LAS u32x2*)(dst + (d0 + 32 * ps) * pitchB + k * 2) = v[ps][u]; }
}
template <int MASK>
__device__ __forceinline__ void att_tile(const LAS unsigned char* kp, const LAS unsigned char* vp0, const LAS unsigned char* vp1, const bf16x8 (&qf)[4], f32x16& o0, f32x16& o1, float& m, float& l, int mi0, bool rowok, const LAS float* tb, int lane) {
    bf16x8 kf[4];
#pragma unroll
    for (int st = 0; st < 4; ++st) kf[st] = *(const LAS bf16x8*)(kp + 32 * st);
    s16x4 v0l[2], v0h[2], v1l[2], v1h[2];
#pragma unroll
    for (int s = 0; s < 2; ++s) { v0l[s] = *(const LAS s16x4*)(vp0 + 32 * s); v0h[s] = *(const LAS s16x4*)(vp0 + 32 * s + 16); v1l[s] = *(const LAS s16x4*)(vp1 + 32 * s); v1h[s] = *(const LAS s16x4*)(vp1 + 32 * s + 16); }
    f32x16 sc;
#pragma unroll
    for (int r = 0; r < 16; ++r) sc[r] = 0.f;
#pragma unroll
    for (int st = 0; st < 4; ++st) sc = MFMA32(kf[st], qf[st], sc);
    if (MASK == 2) {
#pragma unroll
        for (int r = 0; r < 16; ++r) { const int d = mi0 + crow0(r); if ((unsigned)(d + 128) > 256u) sc[r] = NEGBIG; }
    }
    if (MASK == 3) {
#pragma unroll
        for (int r = 0; r < 16; ++r) { const bool ok = rowok && ((unsigned)(crow0(r) - mi0) < 16u); sc[r] = ok ? sc[r] + tb[crow0(r)] : NEGBIG; }
    }
    float mx = sc[0];
#pragma unroll
    for (int r = 1; r < 16; ++r) mx = fmaxf(mx, sc[r]);
    mx = fmaxf(mx, shx(mx, 32, lane));
    const float mn = fmaxf(m, mx), alpha = __builtin_amdgcn_exp2f(m - mn); m = mn;
    float ps = 0.f;
#pragma unroll
    for (int r = 0; r < 16; ++r) { sc[r] = __builtin_amdgcn_exp2f(sc[r] - mn); ps += sc[r]; }
    l = l * alpha + ps;
#pragma unroll
    for (int r = 0; r < 16; ++r) { o0[r] *= alpha; o1[r] *= alpha; }
    u32x4 p0, p1;
    p0.x = pk2(sc[0], sc[1]); p0.y = pk2(sc[2], sc[3]); p0.z = pk2(sc[4], sc[5]); p0.w = pk2(sc[6], sc[7]);
    p1.x = pk2(sc[8], sc[9]); p1.y = pk2(sc[10], sc[11]); p1.z = pk2(sc[12], sc[13]); p1.w = pk2(sc[14], sc[15]);
    const bf16x8 pb0 = __builtin_bit_cast(bf16x8, p0), pb1 = __builtin_bit_cast(bf16x8, p1);
#define VF(lo, hi) (bf16x8){lo[0], lo[1], lo[2], lo[3], hi[0], hi[1], hi[2], hi[3]}
    o0 = MFMA32(VF(v0l[0], v0h[0]), pb0, o0); o0 = MFMA32(VF(v0l[1], v0h[1]), pb1, o0);
    o1 = MFMA32(VF(v1l[0], v1h[0]), pb0, o1); o1 = MFMA32(VF(v1l[1], v1h[1]), pb1, o1);
#undef VF
}
__device__ __forceinline__ float half_max(float v) { const auto rr = __builtin_amdgcn_permlane32_swap(__builtin_bit_cast(unsigned, v), __builtin_bit_cast(unsigned, v), false, false);
    return fmaxf(__builtin_bit_cast(float, rr[0]), __builtin_bit_cast(float, rr[1])); }
template <int MASK, bool LATEV = false>
__device__ __forceinline__ void att_tile2(const LAS unsigned char* kpA, const LAS unsigned char* vA0, const LAS unsigned char* vA1, int miA, bool okA, const LAS float* tbA,
                                          const LAS unsigned char* kpB, const LAS unsigned char* vB0, const LAS unsigned char* vB1, int miB, bool okB, const LAS float* tbB,
                                          const bf16x8 (&qf)[4], f32x16& o0, f32x16& o1, float& m, float& l) {
    f32x16 sa, sb;
#pragma unroll
    for (int r = 0; r < 16; ++r) { sa[r] = 0.f; sb[r] = 0.f; }
    {
        bf16x8 ka[4], kb[4];
#pragma unroll
        for (int st = 0; st < 4; ++st) { ka[st] = *(const LAS bf16x8*)(kpA + 32 * st); kb[st] = *(const LAS bf16x8*)(kpB + 32 * st); }
#pragma unroll
        for (int st = 0; st < 4; ++st) { sa = MFMA32(ka[st], qf[st], sa); sb = MFMA32(kb[st], qf[st], sb); }
    }
    s16x4 a0l[2], a0h[2], a1l[2], a1h[2], b0l[2], b0h[2], b1l[2], b1h[2];
    if (!LATEV) {
#pragma unroll
    for (int s = 0; s < 2; ++s) { a0l[s] = *(const LAS s16x4*)(vA0 + 32 * s); a0h[s] = *(const LAS s16x4*)(vA0 + 32 * s + 16); a1l[s] = *(const LAS s16x4*)(vA1 + 32 * s); a1h[s] = *(const LAS s16x4*)(vA1 + 32 * s + 16);
                                  b0l[s] = *(const LAS s16x4*)(vB0 + 32 * s); b0h[s] = *(const LAS s16x4*)(vB0 + 32 * s + 16); b1l[s] = *(const LAS s16x4*)(vB1 + 32 * s); b1h[s] = *(const LAS s16x4*)(vB1 + 32 * s + 16); }
    }
    if (MASK == 2) {
#pragma unroll
        for (int r = 0; r < 16; ++r) { const int da = miA + crow0(r), db = miB + crow0(r); if ((unsigned)(da + 128) > 256u) sa[r] = NEGBIG; if ((unsigned)(db + 128) > 256u) sb[r] = NEGBIG; }
    }
    if (MASK == 3) {
#pragma unroll
        for (int r = 0; r < 16; ++r) { const bool wa = okA && ((unsigned)(crow0(r) - miA) < 16u), wb = okB && ((unsigned)(crow0(r) - miB) < 16u);
            sa[r] = wa ? sa[r] + tbA[crow0(r)] : NEGBIG; sb[r] = wb ? sb[r] + tbB[crow0(r)] : NEGBIG; }
    }
    float mx = fmaxf(sa[0], sb[0]);
#pragma unroll
    for (int r = 1; r < 16; ++r) mx = fmaxf(mx, fmaxf(sa[r], sb[r]));
    mx = half_max(mx);
    if (__builtin_amdgcn_ballot_w64(mx > m) != 0ull) {
        const float mn = fmaxf(m, mx), alpha = __builtin_amdgcn_exp2f(m - mn); m = mn; l *= alpha;
#pragma unroll
        for (int r = 0; r < 16; ++r) { o0[r] *= alpha; o1[r] *= alpha; }
    }
    float ps = 0.f;
#pragma unroll
    for (int r = 0; r < 16; ++r) { sa[r] = __builtin_amdgcn_exp2f(sa[r] - m); sb[r] = __builtin_amdgcn_exp2f(sb[r] - m); ps += sa[r] + sb[r]; }
    l += ps;
    if (LATEV) { asm volatile("" ::: "memory");
#pragma unroll
    for (int s = 0; s < 2; ++s) { a0l[s] = *(const LAS s16x4*)(vA0 + 32 * s); a0h[s] = *(const LAS s16x4*)(vA0 + 32 * s + 16); a1l[s] = *(const LAS s16x4*)(vA1 + 32 * s); a1h[s] = *(const LAS s16x4*)(vA1 + 32 * s + 16);
                                  b0l[s] = *(const LAS s16x4*)(vB0 + 32 * s); b0h[s] = *(const LAS s16x4*)(vB0 + 32 * s + 16); b1l[s] = *(const LAS s16x4*)(vB1 + 32 * s); b1h[s] = *(const LAS s16x4*)(vB1 + 32 * s + 16); }
    }
    u32x4 pa0, pa1, pb0, pb1;
    pa0.x = pk2(sa[0], sa[1]); pa0.y = pk2(sa[2], sa[3]); pa0.z = pk2(sa[4], sa[5]); pa0.w = pk2(sa[6], sa[7]);
    pa1.x = pk2(sa[8], sa[9]); pa1.y = pk2(sa[10], sa[11]); pa1.z = pk2(sa[12], sa[13]); pa1.w = pk2(sa[14], sa[15]);
    pb0.x = pk2(sb[0], sb[1]); pb0.y = pk2(sb[2], sb[3]); pb0.z = pk2(sb[4], sb[5]); pb0.w = pk2(sb[6], sb[7]);
    pb1.x = pk2(sb[8], sb[9]); pb1.y = pk2(sb[10], sb[11]); pb1.z = pk2(sb[12], sb[13]); pb1.w = pk2(sb[14], sb[15]);
    const bf16x8 qa0 = __builtin_bit_cast(bf16x8, pa0), qa1 = __builtin_bit_cast(bf16x8, pa1), qb0 = __builtin_bit_cast(bf16x8, pb0), qb1 = __builtin_bit_cast(bf16x8, pb1);
#define VF(lo, hi) (bf16x8){lo[0], lo[1], lo[2], lo[3], hi[0], hi[1], hi[2], hi[3]}
    o0 = MFMA32(VF(a0l[0], a0h[0]), qa0, o0); o1 = MFMA32(VF(a1l[0], a1h[0]), qa0, o1);
    o0 = MFMA32(VF(a0l[1], a0h[1]), qa1, o0); o1 = MFMA32(VF(a1l[1], a1h[1]), qa1, o1);
    o0 = MFMA32(VF(b0l[0], b0h[0]), qb0, o0); o1 = MFMA32(VF(b1l[0], b1h[0]), qb0, o1);
    o0 = MFMA32(VF(b0l[1], b0h[1]), qb1, o0); o1 = MFMA32(VF(b1l[1], b1h[1]), qb1, o1);
#undef VF
}
__device__ __forceinline__ int r0_of(int r) { const int v = r - 4; return v < 0 ? 0 : (v > 8 ? 8 : v); }
template <int MODE>
__device__ __forceinline__ void attn_unit(Frame& F, ArgsP args, int layer, int unit, int pm = 0) {
    asm volatile("" : "+s"(args));
    const int tid = opaque_tid(), lane = tid & 63, wave = __builtin_amdgcn_readfirstlane(tid >> 6), q = lane & 31, hh = lane >> 5;
    const bf16_t* Qa = WSP(bf16_t, WS_QA); const bf16_t* Ka = WSP(bf16_t, WS_KA); const bf16_t* VaT = WSP(bf16_t, WS_VAT);
    const bf16_t* Qb = WSP(bf16_t, WS_QB); const bf16_t* Kb = WSP(bf16_t, WS_KB); const bf16_t* VbT = WSP(bf16_t, WS_VBT);
    bf16_t* OC = WSP(bf16_t, WS_OC);
    LAS unsigned char* Ks = F.lds; LAS unsigned char* VTs = F.lds + ATT_VT_OFF;
    LAS float* tab = (LAS float*)(F.lds + TW_OFF);
    constexpr bool isA = (MODE == 0 || MODE == 2);
    int b, head, tokq, kvh;
    int blk = 0, tq0 = 0, seg_lo = 0, NK = 256, rh = 0, ch = 0, qr = 0, qc = 0, qr0w = 0, nblk = 0, klo = 0, nrows = 0, cs_lo = 0;
    if (MODE < 2) { b = unit >> 3; head = unit & 7; tokq = b * 256 + 32 * wave + q; }
    else if (MODE == 2) { b = unit >> 5; const int hp = (unit >> 3) & 3; blk = unit & 7; head = 2 * hp + (wave >> 2); tq0 = 128 * blk + 32 * (wave & 3); tokq = NCTX + b * 1024 + tq0 + q;
        seg_lo = blk == 0 ? 0 : 128 * blk - 128; const int seg_hi = blk == 7 ? 1024 : 128 * blk + 256; NK = seg_hi - seg_lo; }
    else { b = unit >> 5; head = (unit >> 2) & 7; rh = (unit >> 1) & 1; ch = unit & 1; qr0w = 8 * rh + 2 * (wave >> 1); nblk = 2 * ch + (wave & 1); qr = qr0w + (q >> 4); qc = 16 * nblk + (q & 15);
        tokq = NCTX + b * 1024 + qr * 64 + qc; klo = rh ? 4 : 0; nrows = rh ? 12 : 11; cs_lo = ch ? 24 : 0; NK = nrows * 40; }
    kvh = isA ? (head >> 2) : head;
    const int pitchB = (NK + 4) * 2;
    __syncthreads();
    constexpr int NU1 = MODE < 2 ? 4 : (MODE == 2 ? 6 : 8);
    u32x4 rk[NU1]; u32x2 rv[2][NU1]; bf16x8 qf[4]; float rt0 = 0.f, rt1 = 0.f, rsink = 0.f;
    if (MODE == 0) { stage_k_issue<256, NU1>(rk, Ka + (size_t)(b * 256) * 128 + kvh * 64, 256, 0, 128, tid); stage_vt_issue<256, NU1>(rv, VaT + (size_t)((b * 2 + kvh) * 64) * 256, 256, 0, 256, tid); }
    else if (MODE == 1) { stage_k_issue<256, NU1>(rk, Kb + (size_t)(b * 256) * 512 + head * 64, 256, 0, 512, tid); stage_vt_issue<256, NU1>(rv, VbT + (size_t)((b * 8 + head) * 64) * 256, 256, 0, 256, tid); }
    else if (MODE == 2) { stage_k_issue<128, NU1>(rk, Ka + (size_t)(NCTX + b * 1024 + seg_lo) * 128 + kvh * 64, NK, 128, 128, tid);
        stage_vt_issue<128, NU1>(rv, VaT + 524288 + (size_t)((b * 2 + kvh) * 64) * 1024 + seg_lo, NK, 128, 1024, tid); }
    else { stage_k_issue<40, NU1>(rk, Kb + (size_t)(NCTX + b * 1024 + klo * 64 + cs_lo) * 512 + head * 64, NK, 64, 512, tid);
        stage_vt_issue<40, NU1>(rv, VbT + 2097152 + (size_t)((b * 8 + head) * 64) * 1024 + klo * 64 + cs_lo, NK, 64, 1024, tid);
        const float* rp = INP(14) + (size_t)(layer * 8 + head) * 465;
        { const int j0 = tid - 47, j1 = tid + 512 - 47; rt0 = rp[j0 < 0 ? 0 : (j0 > 464 ? 464 : j0)]; rt1 = rp[j1 > 464 ? 464 : j1]; } }
    { const bf16_t* qp = (isA ? Qa : Qb) + (size_t)tokq * 512 + head * 64 + 8 * hh;
#pragma unroll
      for (int st = 0; st < 4; ++st) qf[st] = *(const bf16x8*)(qp + 16 * st); }
    if (isA) rsink = INP(13)[layer * 8 + head];
    if (!(pm & 128)) {
        stage_k_commit<NU1>(rk, Ks, NK, tid); stage_vt_commit<NU1>(rv, VTs, NK, pitchB, tid);
        if (MODE == 3) { const int j0 = tid - 47, j1 = tid + 512 - 47; tab[tid] = (j0 >= 0 && j0 < 465) ? rt0 * LOG2E : 0.f; if (tid + 512 < 640) tab[tid + 512] = (j1 < 465) ? rt1 * LOG2E : 0.f; }
    }
    f32x16 o0, o1;
#pragma unroll
    for (int r = 0; r < 16; ++r) { o0[r] = 0.f; o1[r] = 0.f; }
    float m = MINIT, l = 0.f;
    if (isA) { m = rsink * LOG2E; l = hh == 0 ? 1.f : 0.f; }
    __syncthreads();
    u32x4 ck[4]; u32x2 cv[2][4];
    if (MODE >= 2) { const int bl = b * 2 + layer;
        if (MODE == 2) { stage_k_issue<256, 4>(ck, WSP(bf16_t, WS_CKA) + (size_t)bl * 256 * 128 + kvh * 64, 256, 0, 128, tid); stage_vt_issue<256, 4>(cv, WSP(bf16_t, WS_CVAT) + (size_t)((bl * 2 + kvh) * 64) * 256, 256, 0, 256, tid); }
        else { stage_k_issue<256, 4>(ck, WSP(bf16_t, WS_CKB) + (size_t)bl * 256 * 512 + head * 64, 256, 0, 512, tid); stage_vt_issue<256, 4>(cv, WSP(bf16_t, WS_CVBT) + (size_t)((bl * 8 + head) * 64) * 256, 256, 0, 256, tid); } }
    const LAS unsigned char* kq = Ks + q * ATT_KPITCH + 16 * hh;
    const LAS unsigned char* vq0 = VTs + q * pitchB + 8 * hh;
    const LAS unsigned char* vq1 = vq0 + 32 * pitchB;
    if (pm & 64) {} else
    if (MODE < 2) {
        for (int i = 0; i < 8; i += 2) att_tile2<0>(kq + 32 * i * ATT_KPITCH, vq0 + 64 * i, vq1 + 64 * i, 0, true, tab, kq + 32 * (i + 1) * ATT_KPITCH, vq0 + 64 * (i + 1), vq1 + 64 * (i + 1), 0, true, tab, qf, o0, o1, m, l);
    } else if (MODE == 2) {
        const int slo = tq0 - 128 < 0 ? 0 : tq0 - 128, shi = tq0 + 128 > 992 ? 992 : tq0 + 128;
        int s0 = slo;
        for (; s0 + 32 <= shi; s0 += 64) { const int koff = s0 - seg_lo, mi = s0 - tq0 - q + 4 * hh;
            att_tile2<2>(kq + koff * ATT_KPITCH, vq0 + koff * 2, vq1 + koff * 2, mi, true, tab, kq + (koff + 32) * ATT_KPITCH, vq0 + (koff + 32) * 2, vq1 + (koff + 32) * 2, mi + 32, true, tab, qf, o0, o1, m, l); }
        if (s0 <= shi) { const int koff = s0 - seg_lo;
            att_tile<2>(kq + koff * ATT_KPITCH, vq0 + koff * 2, vq1 + koff * 2, qf, o0, o1, m, l, s0 - tq0 - q + 4 * hh, true, tab, lane); }
    } else {
        const int rlo = r0_of(qr0w), rhi = r0_of(qr0w + 1) + 7; const int cs = nblk == 0 ? 0 : (nblk == 1 ? 8 : (nblk == 2 ? 24 : 32));
        const int r0q = r0_of(qr); int wsq = qc - 8; wsq = wsq < 0 ? 0 : (wsq > 48 ? 48 : wsq);
        const int lo = wsq - cs - 4 * hh;
        int kr = rlo;
        for (; kr + 1 <= rhi; kr += 2) {
            const int koff = (kr - klo) * 40 + (cs - cs_lo); const bool okA = (unsigned)(kr - r0q) < 8u, okB = (unsigned)(kr + 1 - r0q) < 8u;
            const LAS float* tb = tab + (kr - qr + 8) * 31 + (cs + 4 * hh - qc + 15) + 16;
            att_tile2<3>(kq + koff * ATT_KPITCH, vq0 + koff * 2, vq1 + koff * 2, lo, okA, tb, kq + (koff + 40) * ATT_KPITCH, vq0 + (koff + 40) * 2, vq1 + (koff + 40) * 2, lo, okB, tb + 31, qf, o0, o1, m, l);
        }
        if (kr <= rhi) {
            const int koff = (kr - klo) * 40 + (cs - cs_lo); const bool rowok = (unsigned)(kr - r0q) < 8u;
            const LAS float* tb = tab + (kr - qr + 8) * 31 + (cs + 4 * hh - qc + 15) + 16;
            att_tile<3>(kq + koff * ATT_KPITCH, vq0 + koff * 2, vq1 + koff * 2, qf, o0, o1, m, l, lo, rowok, tb, lane);
        }
    }
    if (MODE >= 2 && !(pm & 256)) {
        __syncthreads();
        const int bl = b * 2 + layer; constexpr int pitchC = (256 + 4) * 2;
        if (!(pm & 128)) { stage_k_commit<4>(ck, Ks, 256, tid); stage_vt_commit<4>(cv, VTs, 256, pitchC, tid); }
        __syncthreads();
        const LAS unsigned char* cq0 = VTs + q * pitchC + 8 * hh; const LAS unsigned char* cq1 = cq0 + 32 * pitchC;
        if (!(pm & 64)) for (int i = 0; i < 8; i += 2) att_tile2<0>(kq + 32 * i * ATT_KPITCH, cq0 + 64 * i, cq1 + 64 * i, 0, true, tab, kq + 32 * (i + 1) * ATT_KPITCH, cq0 + 64 * (i + 1), cq1 + 64 * (i + 1), 0, true, tab, qf, o0, o1, m, l);
    }
    const float lt = l + shx(l, 32, lane), inv = 1.0f / lt;
    bf16_t* op = OC + (size_t)tokq * 2048 + (isA ? 0 : 512) + head * 64 + 4 * hh;
#pragma unroll
    for (int g = 0; g < 4; ++g) {
        f32x4 a = {o0[4 * g] * inv, o0[4 * g + 1] * inv, o0[4 * g + 2] * inv, o0[4 * g + 3] * inv};
        f32x4 c = {o1[4 * g] * inv, o1[4 * g + 1] * inv, o1[4 * g + 2] * inv, o1[4 * g + 3] * inv};
        st8(op + 8 * g, pk4(a)); st8(op + 32 + 8 * g, pk4(c));
    }
}

__device__ __forceinline__ void attn_latA_pair(Frame& F, ArgsP args, int layer, int un2) {
    asm volatile("" : "+s"(args));
    const int tid = opaque_tid(), lane = tid & 63, wave = __builtin_amdgcn_readfirstlane(tid >> 6), q = lane & 31, hh = lane >> 5;
    const bf16_t* Qa = WSP(bf16_t, WS_QA); const bf16_t* Ka = WSP(bf16_t, WS_KA); const bf16_t* VaT = WSP(bf16_t, WS_VAT); bf16_t* OC = WSP(bf16_t, WS_OC);
    LAS unsigned char* Ks = F.lds; LAS unsigned char* VTs = F.lds + ATT_VT_OFF; const LAS float* tab = (const LAS float*)(F.lds + TW_OFF);
    const int b = un2 >> 4, kvh = (un2 >> 3) & 1, blk = un2 & 7, bl = b * 2 + layer;
    const int tq0 = 128 * blk + 32 * (wave & 3), tokq = NCTX + b * 1024 + tq0 + q;
    const int seg_lo = blk == 0 ? 0 : 128 * blk - 128, seg_hi = blk == 7 ? 1024 : 128 * blk + 256, NK = seg_hi - seg_lo, pitchB = (NK + 4) * 2;
    __syncthreads();
    u32x4 rk[6]; u32x2 rv[2][6]; bf16x8 qf[2][4]; float rsink[2];
    stage_k_issue<128, 6>(rk, Ka + (size_t)(NCTX + b * 1024 + seg_lo) * 128 + kvh * 64, NK, 128, 128, tid);
    stage_vt_issue<128, 6>(rv, VaT + 524288 + (size_t)((b * 2 + kvh) * 64) * 1024 + seg_lo, NK, 128, 1024, tid);
#pragma unroll
    for (int p = 0; p < 2; ++p) { const int head = 4 * kvh + 2 * p + (wave >> 2); const bf16_t* qp = Qa + (size_t)tokq * 512 + head * 64 + 8 * hh;
#pragma unroll
        for (int st = 0; st < 4; ++st) qf[p][st] = *(const bf16x8*)(qp + 16 * st);
        rsink[p] = INP(13)[layer * 8 + head]; }
    stage_k_commit<6>(rk, Ks, NK, tid); stage_vt_commit<6>(rv, VTs, NK, pitchB, tid);
    f32x16 o0[2], o1[2]; float m[2], l[2];
#pragma unroll
    for (int p = 0; p < 2; ++p) {
#pragma unroll
        for (int r = 0; r < 16; ++r) { o0[p][r] = 0.f; o1[p][r] = 0.f; }
        m[p] = rsink[p] * LOG2E; l[p] = hh == 0 ? 1.f : 0.f; }
    __syncthreads();
    const LAS unsigned char* kq = Ks + q * ATT_KPITCH + 16 * hh;
    {
        const LAS unsigned char* vq0 = VTs + q * pitchB + 8 * hh; const LAS unsigned char* vq1 = vq0 + 32 * pitchB;
        const int slo = tq0 - 128 < 0 ? 0 : tq0 - 128, shi = tq0 + 128 > 992 ? 992 : tq0 + 128;
        int s0 = slo;
        for (; s0 + 32 <= shi; s0 += 64) { const int koff = s0 - seg_lo, mi = s0 - tq0 - q + 4 * hh;
#pragma unroll
            for (int p = 0; p < 2; ++p)
                att_tile2<2, true>(kq + koff * ATT_KPITCH, vq0 + koff * 2, vq1 + koff * 2, mi, true, tab, kq + (koff + 32) * ATT_KPITCH, vq0 + (koff + 32) * 2, vq1 + (koff + 32) * 2, mi + 32, true, tab, qf[p], o0[p], o1[p], m[p], l[p]); }
        if (s0 <= shi) { const int koff = s0 - seg_lo;
#pragma unroll
            for (int p = 0; p < 2; ++p) att_tile<2>(kq + koff * ATT_KPITCH, vq0 + koff * 2, vq1 + koff * 2, qf[p], o0[p], o1[p], m[p], l[p], s0 - tq0 - q + 4 * hh, true, tab, lane); }
    }
    constexpr int pitchC = (256 + 4) * 2;
    { u32x4 ck[4]; u32x2 cv[2][4];
      stage_k_issue<256, 4>(ck, WSP(bf16_t, WS_CKA) + (size_t)bl * 256 * 128 + kvh * 64, 256, 0, 128, tid); stage_vt_issue<256, 4>(cv, WSP(bf16_t, WS_CVAT) + (size_t)((bl * 2 + kvh) * 64) * 256, 256, 0, 256, tid);
      __syncthreads();
      stage_k_commit<4>(ck, Ks, 256, tid); stage_vt_commit<4>(cv, VTs, 256, pitchC, tid); }
    __syncthreads();
    { const LAS unsigned char* cq0 = VTs + q * pitchC + 8 * hh; const LAS unsigned char* cq1 = cq0 + 32 * pitchC;
      for (int i = 0; i < 8; i += 2) {
#pragma unroll
          for (int p = 0; p < 2; ++p)
              att_tile2<0, true>(kq + 32 * i * ATT_KPITCH, cq0 + 64 * i, cq1 + 64 * i, 0, true, tab, kq + 32 * (i + 1) * ATT_KPITCH, cq0 + 64 * (i + 1), cq1 + 64 * (i + 1), 0, true, tab, qf[p], o0[p], o1[p], m[p], l[p]); } }
#pragma unroll
    for (int p = 0; p < 2; ++p) { const int head = 4 * kvh + 2 * p + (wave >> 2);
        const float lt = l[p] + shx(l[p], 32, lane), inv = 1.0f / lt;
        bf16_t* op = OC + (size_t)tokq * 2048 + head * 64 + 4 * hh;
#pragma unroll
        for (int g = 0; g < 4; ++g) {
            f32x4 a = {o0[p][4 * g] * inv, o0[p][4 * g + 1] * inv, o0[p][4 * g + 2] * inv, o0[p][4 * g + 3] * inv};
            f32x4 c = {o1[p][4 * g] * inv, o1[p][4 * g + 1] * inv, o1[p][4 * g + 2] * inv, o1[p][4 * g + 3] * inv};
            st8(op + 8 * g, pk4(a)); st8(op + 32 + 8 * g, pk4(c)); } }
}

struct BranchSched { unsigned A, B; int c, lm;
    __device__ __forceinline__ bool next(int i, pg8::Unit& u) const {
        if (c >= 256 || i >= 4) return false;
        if (lm) (void)pg8::tile_local(0, c, 8, 4, u.pm, u.pn); else pg8::tile_of(c, 64, 4, u.pm, u.pn);
        u.tag = i;
        u.A = A + (unsigned)u.pm * 128u * 2048u * 2u + (unsigned)i * 512u * 2u; u.B = B + (unsigned)i * DM * 512u * 2u + (unsigned)u.pn * 256u * 512u * 2u; return true; } };
struct FourLatSched { unsigned dft, UT; int c;
    __device__ __forceinline__ bool next(int i, pg8::Unit& u) const {
        const int g = c >> 5, j = c & 31; if (j >= 8 || i >= 1) return false;
        const int b = g >> 1, isq = g & 1, mt = j >> 1, nt = j & 1;
        u.pm = (NCTX + b * 1024 + mt * 256) >> 8; u.pn = (1024 + 512 * isq + 256 * nt) >> 8; u.tag = 0;
        u.A = dft + (unsigned)isq * 1024u * 1024u * 2u + (unsigned)mt * 256u * 1024u * 2u; u.B = UT + (2097152u + (unsigned)(b * 512 + nt * 256) * 1024u) * 2u; return true; } };
struct FourCtxSched { unsigned dft, UT; int c;
    __device__ __forceinline__ bool next(int i, pg8::Unit& u) const {
        const int g = c >> 5, j = c & 31; if (j < 8 || j >= 16 || i >= 1) return false;
        const int cc = g * 8 + (j - 8), b = cc >> 2, isq = (cc >> 1) & 1, nt = cc & 1;
        u.pm = b; u.pn = (1024 + 512 * isq + 256 * nt) >> 8; u.tag = 0;
        u.A = dft + (unsigned)isq * 256u * 256u * 2u; u.B = UT + (unsigned)(b * 512 + nt * 256) * 256u * 2u; return true; } };

constexpr int N_PHASES = 2 + 8 * DEPTH;
__global__ void __launch_bounds__(NWAVES * 64, 2) hybrid_fwd(Args args) {
    extern __shared__ __attribute__((aligned(16))) unsigned char lds_raw[];
    Frame F0;
    F0.lds = (LAS unsigned char*)lds_raw;
    F0.lm = 0; F0.G = gridDim.x; { const int bx = blockIdx.x; F0.vcu = (F0.G % 8 == 0) ? (bx % 8) * (F0.G / 8) + bx / 8 : bx; }
    ArgsP ap0 = (ArgsP)__builtin_amdgcn_kernarg_segment_ptr();
    asm volatile("" : "+s"(ap0));
    F0.out = (GAS float*)ap0->out; F0.ws = (GAS unsigned char*)ap0->ws;
    const int tid = threadIdx.x;
    volatile LAS unsigned* MISC = (volatile LAS unsigned*)(F0.lds + MISC_OFF);
    for (int u = tid; u < 256; u += NWAVES * 64) ((LAS unsigned*)(F0.lds + LDSCTL_OFF))[u] = 0u;
    __syncthreads();
    XcdBarrier bar; bar.bar = (unsigned*)(F0.ws + WS_CTL) + CW_BAR; bar.x = 0; bar.st = nullptr;
    if (!MK_PER_PHASE) bar = xcd_barrier_post((unsigned*)(F0.ws + WS_CTL) + CW_BAR, MISC + 8);
    const int lo = ap0->ph_lo, hi = ap0->ph_hi;
    const int bx0 = (int)blockIdx.x;
    for (int pass = 0; pass <= PROBE_TWICE; ++pass) {
    if (pass > 0) xcd_barrier(bar);
    int rep = 0;
    for (int ph = lo; ph < hi; ++ph) {
      {
        Frame F = F0; ArgsP ap = ap0; int bx = bx0;
        asm volatile("" : "+s"(F.ws), "+s"(F.out), "+s"(F.vcu), "+s"(F.G), "+s"(F.lm), "+s"(ap), "+s"(bx));
        const int cu = F.lm ? F.vcu : bx;
        if (ph == 0) { if (!(DIS & 1)) { p0_prologue(F, ap); row_phase(F, ap, 0, 0); } }
        else if (ph == 1) { continue; }
        else {
            const int l = (ph - 2) >> 3, k = (ph - 2) & 7; const int prep = (ph >= PROBE_PH && ph <= PROBE_HI && rep + 1 < PROBE_REP) ? 1 : 0; (void)prep;
            const unsigned wlo = (unsigned)WS_W + (unsigned)l * (unsigned)W_LAYER;
            if (k == 0) {
                pg8::GridSched S{(unsigned)WS_H, wlo + (unsigned)W_IN, 32, DIN / 256, F.G, cu, 256u * DM * 2u, 256u * DM * 2u, F.lm};
                pg8::EpiIn E{F.ws, F.out, l};
#if PROBE_EPI
                if (prep > 0) { pg8::EpiBf16Probe E2{WSP(bf16_t, WS_OC), 2048}; pg8::gemm_phase(F.lds, (const unsigned char*)F.ws, pg8::Dims{DM, DM, DM}, S, E2); } else
#endif
                if (!(DIS & 4)) pg8::gemm_phase(F.lds, (const unsigned char*)F.ws, pg8::Dims{DM, DM, DM}, S, E);
            } else if (k == 1) {
                pg8::EpiBf16 E{WSP(bf16_t, WS_OC), 2048};
                if (prep == 0 || !(PROBE_SKIP & 1)) { FourLatSched S{(unsigned)WS_DFTL, (unsigned)WS_UT, F.vcu}; if (!(DIS & 8)) pg8::gemm_phase(F.lds, (const unsigned char*)F.ws, pg8::Dims{1024, 1024, 1024}, S, E); }
                if (prep == 0 || !(PROBE_SKIP & 1)) { FourCtxSched S{(unsigned)WS_DFTC, (unsigned)WS_UT, F.vcu}; if (!(DIS & 8)) pg8::gemm_phase(F.lds, (const unsigned char*)F.ws, pg8::Dims{256, 256, 256}, S, E); }
                if (!(DIS & 16) && (prep == 0 || !(PROBE_SKIP & 2))) {
                    const int g = F.vcu >> 5, j = F.vcu & 31, pmk = prep ? PROBE_SKIP : 0;
                    auto ctx = [&](int id) { if (id < 128) attn_unit<0>(F, ap, l, id, pmk); else attn_unit<1>(F, ap, l, id - 128, pmk); };
                    if (j < 8) ctx(g * 32 + j);
                    else if (j < 16) { attn_unit<3>(F, ap, l, g * 16 + (j - 8), pmk); ctx(g * 32 + j); }
                    else if (j < 24) attn_latA_pair(F, ap, l, g * 8 + (j - 16));
                    else { attn_unit<3>(F, ap, l, g * 16 + 8 + (j - 24), pmk); ctx(g * 32 + 16 + 2 * (j - 24)); ctx(g * 32 + 17 + 2 * (j - 24)); }
                }
            } else if (k == 2) {
                BranchSched S{(unsigned)WS_OC, wlo + (unsigned)W_BR, cu, F.lm};
                pg8::EpiBranch E{WSP(bf16_t, WS_G), WSP(bf16_t, WS_MB)};
                if (!(DIS & 32)) pg8::gemm_phase_hm(F.lds, (const unsigned char*)F.ws, pg8::Dims{512, 2048, 512}, S, E);
            } else if (k == 3) {
                pg8::GridSched S{(unsigned)WS_MB, wlo + (unsigned)W_OUT, 64, 4, F.G, cu, 128u * DM * 2u, 256u * DM * 2u, F.lm};
#if FUSED_ROWS
                pg8::EpiRow E{F.ws, F.out, (const float*)(const GAS float*)ap->in[0], (const float*)(const GAS float*)ap->in[1], (const float*)(const GAS float*)ap->in[10], (const float*)(const GAS float*)ap->in[11], F.lds, l, 1};
#else
                pg8::EpiBf16 E{WSP(bf16_t, WS_Y), DM};
#endif
                if (!(DIS & 64)) pg8::gemm_phase_hm(F.lds, (const unsigned char*)F.ws, pg8::Dims{DM, DM, DM}, S, E);
            } else if (k == 4) { if (FUSED_ROWS) continue; if (!(DIS & 2)) row_phase(F, ap, l, 1); }
            else if (k == 5) {
                pg8::GridSched S{(unsigned)WS_H, wlo + (unsigned)W_F1, 32, DFF2 / 256, F.G, cu, 256u * DM * 2u, 256u * DM * 2u, F.lm};
                pg8::EpiSwiGLU E{WSP(bf16_t, WS_AB)};
                if (!(DIS & 128)) pg8::gemm_phase(F.lds, (const unsigned char*)F.ws, pg8::Dims{DM, DM, DM}, S, E);
            } else if (k == 6) {
                pg8::GridSched S{(unsigned)WS_AB, wlo + (unsigned)W_F2, 64, 4, F.G, cu, 128u * DFF * 2u, 256u * DFF * 2u, F.lm};
#if FUSED_ROWS
                pg8::EpiRow E{F.ws, F.out, (const float*)(const GAS float*)ap->in[0], (const float*)(const GAS float*)ap->in[1], (const float*)(const GAS float*)ap->in[10], (const float*)(const GAS float*)ap->in[11], F.lds, l, 2};
#else
                pg8::EpiBf16 E{WSP(bf16_t, WS_Y), DM};
#endif
                if (!(DIS & 256)) pg8::gemm_phase_hm(F.lds, (const unsigned char*)F.ws, pg8::Dims{DFF, DFF, DFF}, S, E);
            } else { if (FUSED_ROWS) continue; if (!(DIS & 2)) row_phase(F, ap, l, 2); }
        }
      }
        if (ph == PROBE_HI && rep + 1 < PROBE_REP) { ++rep; ph = PROBE_PH - 1; xcd_barrier(bar); continue; }
        if (ph + 1 < hi) {
            const int kk = (ph - 2) & 7;
            if (F0.lm && ph >= 2 && (kk == 2 || kk == 3 || kk == 5 || kk == 6)) xcd_local_barrier(bar);
            else xcd_barrier(bar);
            for (int eb = 0; eb < PROBE_BAR; ++eb) xcd_barrier(bar);
            if (ph == 0 && !MK_PER_PHASE) {
                const int lm = (int)__builtin_amdgcn_readfirstlane(MISC[10]);
                if (lm) { F0.lm = 1; F0.vcu = (int)__builtin_amdgcn_readfirstlane(MISC[12]) * 32 + (int)__builtin_amdgcn_readfirstlane(MISC[11]); }
            }
        }
    }
    }
}

extern "C" void kernel_launch(void* const* d_in, const int* in_sizes, int n_in, void* d_out, int out_size, void* d_ws, size_t ws_size, hipStream_t stream) {
    static int grid = 0;
    if (grid == 0) {
        if (n_in != 19 || out_size != OUT_TOTAL || ws_size < WS_END) { fprintf(stderr, "kernel_launch: unexpected shapes: n_in %d out %d ws %zu\n", n_in, out_size, ws_size); grid = -1; return; }
        int dev = 0, cus = 0, per_cu = 0;
        if (hipGetDevice(&dev) != hipSuccess || hipDeviceGetAttribute(&cus, hipDeviceAttributeMultiprocessorCount, dev) != hipSuccess) { grid = -1; return; }
        if (hipFuncSetAttribute((const void*)hybrid_fwd, hipFuncAttributeMaxDynamicSharedMemorySize, LDS_BYTES) != hipSuccess) { fprintf(stderr, "kernel_launch: hipFuncSetAttribute failed\n"); grid = -1; return; }
        if (hipOccupancyMaxActiveBlocksPerMultiprocessor(&per_cu, (const void*)hybrid_fwd, NWAVES * 64, LDS_BYTES) != hipSuccess || per_cu < 1) { fprintf(stderr, "kernel_launch: occupancy query says %d blocks per CU\n", per_cu); (void)hipGetLastError(); grid = -1; return; }
        grid = cus;
    }
    if (grid < 0) return;
    (void)hipMemsetAsync((char*)d_ws + WS_CTL, 0, CTL_ZERO_BYTES, stream);
    Args a{};
    for (int i = 0; i < 19; ++i) a.in[i] = (const float*)d_in[i];
    a.out = (float*)d_out; a.ws = (unsigned char*)d_ws;
#if MK_PER_PHASE
    for (int ph = 0; ph < N_PHASES; ++ph) { a.ph_lo = ph; a.ph_hi = ph + 1; hipLaunchKernelGGL(hybrid_fwd, dim3(grid), dim3(NWAVES * 64), LDS_BYTES, stream, a); }
#else
    a.ph_lo = 0; a.ph_hi = N_PHASES;
    hipLaunchKernelGGL(hybrid_fwd, dim3(grid), dim3(NWAVES * 64), LDS_BYTES, stream, a);
#endif
}
```

```cpp
#include <hip/hip_runtime.h>
#include <cstdio>
#include <cstdint>

#ifndef MK_PER_PHASE
#define MK_PER_PHASE 0
#endif

#ifndef DIS
#define DIS 0
#endif
#ifndef PROBE_PH
#define PROBE_PH -1
#define PROBE_REP 1
#endif
#ifndef PROBE_HI
#define PROBE_HI PROBE_PH
#endif
#ifndef FUSED_ROWS
#define FUSED_ROWS 1
#endif
#ifndef PROBE_EPI
#define PROBE_EPI 0
#endif
#ifndef PROBE_BAR
#define PROBE_BAR 0
#endif
#ifndef PROBE_TWICE
#define PROBE_TWICE 0
#endif
#ifndef PREREAD
#define PREREAD 0
#endif
#ifndef PROBE_SKIP
#define PROBE_SKIP 0
#endif
#define LAS __attribute__((address_space(3)))
#define GAS __attribute__((address_space(1)))
typedef unsigned short bf16_t;
typedef short bf16x8 __attribute__((ext_vector_type(8)));
typedef short s16x4 __attribute__((ext_vector_type(4)));
typedef float f32x4 __attribute__((ext_vector_type(4)));
typedef float f32x2 __attribute__((ext_vector_type(2)));
typedef float f32x16 __attribute__((ext_vector_type(16)));
typedef unsigned u32x4 __attribute__((ext_vector_type(4)));
typedef unsigned u32x2 __attribute__((ext_vector_type(2)));
typedef __bf16 bf16x2_t __attribute__((ext_vector_type(2)));

constexpr int DM = 1024, NTOK = 8192, NCTX = 4096, DEPTH = 2, DIN = 5888, DFF = 2816, DFF2 = 5632;
constexpr int OUT_NAK = 8388608, OUT_NAV = 9437184, OUT_NBK = 10485760, OUT_NBV = 14680064, OUT_TOTAL = 18874368;
constexpr float LOG2E = 1.4426950408889634f;
constexpr float QSCALE = 0.125f * LOG2E;
constexpr float NORM_EPS = 1e-6f;
constexpr float NEGBIG = -1e30f, MINIT = -1e20f;

constexpr size_t MiB = 1u << 20;
constexpr size_t WS_CTL = 0, CTL_ZERO_BYTES = 64 * 1024;
constexpr size_t WS_MOD = 1 * MiB;
constexpr size_t WS_ROPEC = 1 * MiB + 256 * 1024;
constexpr size_t WS_ROPES = 1 * MiB + 384 * 1024;
constexpr size_t WS_DFTC = 2 * MiB;
constexpr size_t WS_CKA = 3 * MiB, WS_CVAT = 3 * MiB + 512 * 1024;
constexpr size_t WS_CKB = 4 * MiB, WS_CVBT = 6 * MiB;
constexpr size_t WS_DFTL = 8 * MiB;
constexpr size_t WS_W = 12 * MiB, W_LAYER = 34 * MiB;
constexpr size_t W_IN = 0, W_BR = 11 * MiB + 512 * 1024, W_OUT = W_BR + 4 * MiB, W_F1 = W_OUT + 2 * MiB, W_F2 = W_F1 + 11 * MiB;
constexpr size_t WS_H = 80 * MiB;
constexpr size_t WS_QA = 96 * MiB, WS_KA = 104 * MiB, WS_VAT = 106 * MiB, WS_QB = 108 * MiB, WS_KB = 116 * MiB, WS_VBT = 124 * MiB, WS_UT = 132 * MiB;
constexpr size_t WS_MB = 240 * MiB;
constexpr size_t WS_G = 184 * MiB;
constexpr int GPITCH = 3072;
constexpr size_t WS_AB = 140 * MiB;
constexpr size_t WS_OC = 208 * MiB;
constexpr size_t WS_Y = 208 * MiB;
constexpr size_t WS_END = 256 * MiB;
static_assert(W_F2 + 5 * MiB + 512 * 1024 == W_LAYER, "weight map");
constexpr size_t WS_XS = 1 * MiB + 512 * 1024;
constexpr int CW_XCNT = 8192;
constexpr int CW_MODCNT = 512;
constexpr int CW_BAR = 1024;

constexpr int RING_BYTES = 147456;
constexpr int LDSCTL_OFF = RING_BYTES, MISC_OFF = LDSCTL_OFF + 320;
constexpr int TW_OFF = RING_BYTES + 1024;
constexpr int EXCH_OFF = 155648;
constexpr int LDS_BYTES = 163840;
constexpr int NWAVES = 8;

__device__ __forceinline__ unsigned f2bf(float f) { unsigned u = __builtin_bit_cast(unsigned, f); return (u + 0x7fffu + ((u >> 16) & 1u)) >> 16; }
__device__ __forceinline__ unsigned pk2(float lo, float hi) { f32x2 v = {lo, hi}; bf16x2_t b = __builtin_convertvector(v, bf16x2_t); return __builtin_bit_cast(unsigned, b); }
__device__ __forceinline__ u32x2 pk4(f32x4 v) { u32x2 r; r.x = pk2(v[0], v[1]); r.y = pk2(v[2], v[3]); return r; }
__device__ __forceinline__ void st8(void* p, u32x2 v) { *(u32x2*)p = v; }
__device__ __forceinline__ void st16f(float* p, f32x4 v) { *(f32x4*)p = v; }
__device__ __forceinline__ void st16u(void* p, u32x4 v) { *(u32x4*)p = v; }
__device__ __forceinline__ void st2(bf16_t* p, unsigned v) { *p = (bf16_t)v; }
__device__ __forceinline__ float bf2f(unsigned short b) { return __builtin_bit_cast(float, (unsigned)b << 16); }
__device__ __forceinline__ f32x4 ld_bf4(const bf16_t* p) { const u32x2 w = *(const u32x2*)p; f32x4 r; r[0] = __builtin_bit_cast(float, w.x << 16); r[1] = __builtin_bit_cast(float, w.x & 0xffff0000u);
    r[2] = __builtin_bit_cast(float, w.y << 16); r[3] = __builtin_bit_cast(float, w.y & 0xffff0000u); return r; }
__device__ __forceinline__ unsigned pk_gate4(f32x4 g) { unsigned r = 0;
    r = __builtin_amdgcn_cvt_pk_u8_f32(g[0] * 256.f - 0.5f, 0, r); r = __builtin_amdgcn_cvt_pk_u8_f32(g[1] * 256.f - 0.5f, 1, r);
    r = __builtin_amdgcn_cvt_pk_u8_f32(g[2] * 256.f - 0.5f, 2, r); r = __builtin_amdgcn_cvt_pk_u8_f32(g[3] * 256.f - 0.5f, 3, r); return r; }
__device__ __forceinline__ f32x4 un_gate4(unsigned w) { f32x4 r;
    r[0] = (float)(w & 0xffu); r[1] = (float)((w >> 8) & 0xffu); r[2] = (float)((w >> 16) & 0xffu); r[3] = (float)(w >> 24);
    return r * (1.f / 256.f) + (0.5f / 256.f); }
__device__ __forceinline__ u32x4 pair16(u32x2 a, u32x2 b) { const auto rx = __builtin_amdgcn_permlane16_swap(a.x, b.x, false, false); const auto ry = __builtin_amdgcn_permlane16_swap(a.y, b.y, false, false);
    u32x4 o; o.x = rx[0]; o.y = ry[0]; o.z = rx[1]; o.w = ry[1]; return o; }
__device__ __forceinline__ void unpair16(u32x4 o, u32x2& a, u32x2& b) { const auto rx = __builtin_amdgcn_permlane16_swap(o.x, o.z, false, false); const auto ry = __builtin_amdgcn_permlane16_swap(o.y, o.w, false, false);
    a.x = rx[0]; a.y = ry[0]; b.x = rx[1]; b.y = ry[1]; }
__device__ __forceinline__ f32x4 bf4_to_f32(u32x2 w) { f32x4 r; r[0] = __builtin_bit_cast(float, w.x << 16); r[1] = __builtin_bit_cast(float, w.x & 0xffff0000u); r[2] = __builtin_bit_cast(float, w.y << 16); r[3] = __builtin_bit_cast(float, w.y & 0xffff0000u); return r; }
__device__ __forceinline__ u32x4 pair32(u32x2 x, u32x2 y) { const auto rx = __builtin_amdgcn_permlane32_swap(x.x, y.x, false, false); const auto ry = __builtin_amdgcn_permlane32_swap(x.y, y.y, false, false);
    u32x4 o; o.x = rx[0]; o.y = ry[0]; o.z = rx[1]; o.w = ry[1]; return o; }
__device__ __forceinline__ int pair16_col(int fq) { return (fq & 1) ? 16 + 4 * (fq - 1) : 4 * fq; }
__device__ __forceinline__ float fmax_nc(float a, float b) { return __builtin_elementwise_maximum(a, b); }
typedef float f32x2v __attribute__((ext_vector_type(2)));
__device__ __forceinline__ float shx(float v, int o, int lane) { return __builtin_bit_cast(float, __builtin_amdgcn_ds_bpermute((lane ^ o) << 2, __builtin_bit_cast(int, v))); }
__device__ __forceinline__ float wave_sum(float v, int lane) {
#pragma unroll
    for (int o = 1; o < 64; o <<= 1) v += shx(v, o, lane);
    return v;
}
__device__ __forceinline__ float fast_rcp(float x) { return __builtin_amdgcn_rcpf(x); }
__device__ __forceinline__ float sigmoidf_(float x) { x = fminf(fmaxf(x, -30.f), 30.f); return fast_rcp(1.f + __builtin_amdgcn_exp2f(-x * LOG2E)); }

__device__ __forceinline__ int opaque_tid() { int t = threadIdx.x; asm volatile("" : "+v"(t)); return t; }
namespace pg8 {
constexpr int BM = 256, BK = 64, HALF = 128, HTB = HALF * BK * 2, STAGE_BYTES = 8 * HTB, NXCD = 8, WGM = 8;
__host__ __device__ __forceinline__ int lds_byte(int r, int c) { const int st = (r >> 4) * 2 + (c >> 5), rr = r & 15, cc = c & 31, ob = rr * 64 + cc * 2; return st * 1024 + (ob ^ (((ob >> 9) & 1) << 5)); }
__host__ __device__ __forceinline__ void stage_rc(int b, int& R, int& C) { const int st = b / 1024, sb = b % 1024, swz = sb ^ (((sb >> 9) & 1) << 5); R = (st >> 1) * 16 + swz / 64; C = (st & 1) * 32 + (swz % 64) / 2; }

struct Unit { int pm, pn, tag; unsigned A, B; };
struct Dims { int K, lda, ldb; };

__device__ __forceinline__ void tile_of(int L, int nM, int nN, int& pm, int& pn) {
    const int nwg = nM * nN; int wgid = L;
    { const int q = nwg / NXCD, r = nwg % NXCD, xcd = wgid % NXCD, off = wgid / NXCD; wgid = (xcd < r ? xcd * (q + 1) : r * (q + 1) + (xcd - r) * q) + off; }
    const int nig = WGM * nN, gid = wgid / nig, fm = gid * WGM, gsz = (nM - fm) < WGM ? (nM - fm) : WGM;
    pm = fm + ((wgid % nig) % gsz); pn = (wgid % nig) / gsz;
}
__device__ __forceinline__ bool tile_local(int i, int c, int mpx, int nN, int& pm, int& pn) {
    const int L = i * 32 + (c & 31); if (L >= mpx * nN) return false;
    const int g = c >> 5, i2 = L & (mpx - 1), hf = mpx >> 1;
    pm = i2 < hf ? g * hf + i2 : 4 * mpx + g * hf + (i2 - hf); pn = L / mpx; return true; }
struct GridSched {
    unsigned A, B; int nM, nN, G, c; unsigned tA, tB; int lm;
    __device__ __forceinline__ bool next(int i, Unit& u) const {
        if (lm) { if (!tile_local(i, c, nM >> 3, nN, u.pm, u.pn)) return false; }
        else { const int L = i * G + c; if (L >= nM * nN) return false; tile_of(L, nM, nN, u.pm, u.pn); }
        u.tag = 0; u.A = A + (unsigned)u.pm * tA; u.B = B + (unsigned)u.pn * tB; return true;
    }
};

template <class Epi, class Sched>
__device__ __forceinline__ void gemm_phase(LAS unsigned char* lds, const unsigned char* wsb, const Dims g, const Sched& S, const Epi& E) {
    const int tid = opaque_tid(), wid = __builtin_amdgcn_readfirstlane(tid >> 6), lane = tid & 63, wr = wid >> 2, wc = wid & 3, fr = lane & 15, fq = lane >> 4;
    int K = g.K, lda_ = g.lda, ldb_ = g.ldb;
    asm volatile("" : "+s"(K), "+s"(lda_), "+s"(ldb_));
    const int nt = K / BK;
    unsigned voffA, voffB;
    { const int b = tid * 16, R = b >> 7, C = (((b >> 4) & 7) ^ (R & 7)) * 8; voffA = (unsigned)(R * lda_ + C) * 2u; voffB = (unsigned)(R * ldb_ + C) * 2u; }
    const unsigned qvoffA = 64u * lda_ * 2u, qvoffB = 64u * ldb_ * 2u;
    constexpr unsigned kstep = BK * 2;
    constexpr int aux_voffA = 0, aux_voffB = 0;
    const unsigned hstepA = (unsigned)HALF * lda_ * 2u, hstepB = (unsigned)HALF * ldb_ * 2u;
    const unsigned ldsw = (unsigned)wid * 1024u;
    const int aoff0 = (wr * 64 + fr) * 128 + ((fq ^ (fr & 7)) << 4), aoff1 = aoff0 ^ 64, boff0 = (wc * 32 + fr) * 128 + ((fq ^ (fr & 7)) << 4), boff1 = boff0 ^ 64;
#define PG8_SA(b, h) (((b) * 2 + (h)) * HTB)
#define PG8_SB(b, h) ((4 + (b) * 2 + (h)) * HTB)
#define PG8_STAGE(bufoff, gbase, voff) do { _Pragma("unroll") for (int _i = 0; _i < 2; ++_i) \
        __builtin_amdgcn_global_load_lds((const unsigned*)((const char*)wsb + (size_t)((gbase) + _i * q##voff) + (voff)), (LAS unsigned*)(lds + (bufoff) + ldsw + _i * 8192), 16, 0, aux_##voff); } while (0)
#define PG8_LDA(dst, b, h) do { _Pragma("unroll") for (int m = 0; m < 4; ++m) _Pragma("unroll") for (int k = 0; k < 2; ++k) dst[m][k] = *(const LAS bf16x8*)(lds + PG8_SA(b, h) + (k ? aoff1 : aoff0) + m * 2048); } while (0)
#define PG8_LDB(dst, b, h) do { _Pragma("unroll") for (int n = 0; n < 2; ++n) _Pragma("unroll") for (int k = 0; k < 2; ++k) dst[n][k] = *(const LAS bf16x8*)(lds + PG8_SB(b, h) + (k ? boff1 : boff0) + n * 2048); } while (0)
#define PG8_MMA(ai, bj, At, Bt) do { __builtin_amdgcn_s_setprio(1); _Pragma("unroll") for (int m = 0; m < 4; ++m) _Pragma("unroll") for (int n = 0; n < 2; ++n) _Pragma("unroll") for (int k = 0; k < 2; ++k) \
        acc[ai][bj][m][n] = __builtin_amdgcn_mfma_f32_16x16x32_bf16(Bt[n][k], At[m][k], acc[ai][bj][m][n], 0, 0, 0); __builtin_amdgcn_s_setprio(0); } while (0)
#define PG8_WAIT_V(n) asm volatile("s_waitcnt vmcnt(" #n ")" ::: "memory")
#define PG8_WAIT_L(n) asm volatile("s_waitcnt lgkmcnt(" #n ")" ::: "memory")
#define PG8_BAR __builtin_amdgcn_s_barrier()
#define PG8_SCHED __builtin_amdgcn_sched_barrier(0)
    Unit cur, nxt; int ui = 0;
    if (!S.next(0, cur)) return;
    f32x4 acc[2][2][4][2];
#pragma unroll
    for (int a = 0; a < 2; ++a)
#pragma unroll
        for (int b = 0; b < 2; ++b)
#pragma unroll
            for (int m = 0; m < 4; ++m)
#pragma unroll
                for (int n = 0; n < 2; ++n) acc[a][b][m][n] = (f32x4){0.f, 0.f, 0.f, 0.f};
    bf16x8 At[4][2], B0[2][2], B1[2][2];
    unsigned cA = cur.A, cB = cur.B;
    PG8_STAGE(PG8_SB(0, 0), cB, voffB); PG8_STAGE(PG8_SB(0, 1), cB + hstepB, voffB); PG8_STAGE(PG8_SA(0, 0), cA, voffA); PG8_STAGE(PG8_SA(0, 1), cA + hstepA, voffA);
    if (wr == 1) PG8_BAR;
    PG8_WAIT_V(2); PG8_BAR;
    PG8_STAGE(PG8_SB(1, 0), cB + kstep, voffB); PG8_STAGE(PG8_SA(1, 0), cA + kstep, voffA); PG8_STAGE(PG8_SB(1, 1), cB + hstepB + kstep, voffB);
    PG8_WAIT_V(6); PG8_BAR;
    for (;;) {
        const bool has_next = S.next(ui + 1, nxt);
        const unsigned nA = has_next ? nxt.A : cA, nB = has_next ? nxt.B : cB;
        for (int t = 0; t < nt; t += 2) {
            const bool last = (t == nt - 2);
            const unsigned a1 = cA + (unsigned)(t + 1) * kstep;
            const unsigned a2 = last ? nA : cA + (unsigned)(t + 2) * kstep, b2 = last ? nB : cB + (unsigned)(t + 2) * kstep;
            const unsigned a3 = a2 + kstep, b3 = b2 + kstep;
            PG8_LDB(B0, 0, 0); PG8_LDB(B1, 0, 1); PG8_SCHED; PG8_LDA(At, 0, 0); PG8_STAGE(PG8_SA(1, 1), a1 + hstepA, voffA);
            PG8_WAIT_V(8); PG8_WAIT_L(0); PG8_BAR; PG8_MMA(0, 0, At, B0); PG8_MMA(0, 1, At, B1); PG8_BAR; PG8_SCHED;
            PG8_LDA(At, 0, 1); PG8_STAGE(PG8_SB(0, 0), b2, voffB); PG8_STAGE(PG8_SB(0, 1), b2 + hstepB, voffB); PG8_STAGE(PG8_SA(0, 0), a2, voffA);
            PG8_WAIT_V(8); PG8_WAIT_L(0); PG8_BAR; PG8_MMA(1, 0, At, B0); PG8_MMA(1, 1, At, B1); PG8_BAR; PG8_SCHED;
            PG8_LDB(B0, 1, 0); PG8_LDB(B1, 1, 1); PG8_SCHED; PG8_LDA(At, 1, 0); PG8_STAGE(PG8_SA(0, 1), a2 + hstepA, voffA);
            PG8_WAIT_V(8); PG8_WAIT_L(0); PG8_BAR; PG8_MMA(0, 0, At, B0); PG8_MMA(0, 1, At, B1); PG8_BAR; PG8_SCHED;
            PG8_LDA(At, 1, 1); PG8_STAGE(PG8_SB(1, 0), b3, voffB); PG8_STAGE(PG8_SB(1, 1), b3 + hstepB, voffB); PG8_STAGE(PG8_SA(1, 0), a3, voffA);
            PG8_WAIT_V(8); PG8_WAIT_L(0); PG8_BAR; PG8_MMA(1, 0, At, B0); PG8_MMA(1, 1, At, B1); PG8_BAR; PG8_SCHED;
        }
        if (wr == 0) PG8_BAR;
        const bool keep = E.template run<2>(acc, cur, wr, wc, fr, fq);
        if (!has_next) break;
        if (!keep) {
#pragma unroll
            for (int a = 0; a < 2; ++a)
#pragma unroll
                for (int b = 0; b < 2; ++b)
#pragma unroll
                    for (int m = 0; m < 4; ++m)
#pragma unroll
                        for (int n = 0; n < 2; ++n) acc[a][b][m][n] = (f32x4){0.f, 0.f, 0.f, 0.f};
        }
        cur = nxt; cA = nA; cB = nB; ++ui;
        if (wr == 1) PG8_BAR;
    }
    PG8_WAIT_V(0);
    PG8_BAR;
#undef PG8_SA
#undef PG8_SB
#undef PG8_STAGE
#undef PG8_LDA
#undef PG8_LDB
#undef PG8_MMA
#undef PG8_WAIT_V
#undef PG8_WAIT_L
#undef PG8_BAR
#undef PG8_SCHED
}


template <class Epi, class Sched>
__device__ __forceinline__ void gemm_phase_hm(LAS unsigned char* lds, const unsigned char* wsb, const Dims g, const Sched& S, const Epi& E) {
    const int tid = opaque_tid(), wid = __builtin_amdgcn_readfirstlane(tid >> 6), lane = tid & 63, wr = wid >> 2, wc = wid & 3, fr = lane & 15, fq = lane >> 4;
    int K = g.K, lda_ = g.lda, ldb_ = g.ldb;
    asm volatile("" : "+s"(K), "+s"(lda_), "+s"(ldb_));
    const int nt = K / BK;
    unsigned voffA, voffB;
    { const int b = tid * 16, R = b >> 7, C = (((b >> 4) & 7) ^ (R & 7)) * 8; voffA = (unsigned)(R * lda_ + C) * 2u; voffB = (unsigned)(R * ldb_ + C) * 2u; }
    const unsigned qvoffA = 64u * lda_ * 2u, qvoffB = 64u * ldb_ * 2u;
    constexpr unsigned kstep = BK * 2;
    constexpr int aux_voffA = 0, aux_voffB = 0;
    const unsigned hstepB = (unsigned)HALF * ldb_ * 2u;
    const unsigned ldsw = (unsigned)wid * 1024u;
    const int aoff0 = (wr * 64 + fr) * 128 + ((fq ^ (fr & 7)) << 4), aoff1 = aoff0 ^ 64, boff0 = (wc * 32 + fr) * 128 + ((fq ^ (fr & 7)) << 4), boff1 = boff0 ^ 64;
    constexpr int SLOT = 3 * HTB;
#define HM_STAGE(bufoff, gbase, voff) do { _Pragma("unroll") for (int _i = 0; _i < 2; ++_i) \
        __builtin_amdgcn_global_load_lds((const unsigned*)((const char*)wsb + (size_t)((gbase) + _i * q##voff) + (voff)), (LAS unsigned*)(lds + (bufoff) + ldsw + _i * 8192), 16, 0, aux_##voff); } while (0)
#define HM_STAGE3(so, gb, ga) do { HM_STAGE((so), (gb), voffB); HM_STAGE((so) + HTB, (gb) + hstepB, voffB); HM_STAGE((so) + 2 * HTB, (ga), voffA); } while (0)
#define HM_LDA(dst, so) do { _Pragma("unroll") for (int m = 0; m < 4; ++m) _Pragma("unroll") for (int k = 0; k < 2; ++k) dst[m][k] = *(const LAS bf16x8*)(lds + (so) + 2 * HTB + (k ? aoff1 : aoff0) + m * 2048); } while (0)
#define HM_LDB(dst, so, h) do { _Pragma("unroll") for (int n = 0; n < 2; ++n) _Pragma("unroll") for (int k = 0; k < 2; ++k) dst[n][k] = *(const LAS bf16x8*)(lds + (so) + (h) * HTB + (k ? boff1 : boff0) + n * 2048); } while (0)
#define HM_MMA(bj, At, Bt) do { __builtin_amdgcn_s_setprio(1); _Pragma("unroll") for (int m = 0; m < 4; ++m) _Pragma("unroll") for (int n = 0; n < 2; ++n) _Pragma("unroll") for (int k = 0; k < 2; ++k) \
        acc[0][bj][m][n] = __builtin_amdgcn_mfma_f32_16x16x32_bf16(Bt[n][k], At[m][k], acc[0][bj][m][n], 0, 0, 0); __builtin_amdgcn_s_setprio(0); } while (0)
#define HM_WAIT_V(n) asm volatile("s_waitcnt vmcnt(" #n ")" ::: "memory")
#define HM_WAIT_L(n) asm volatile("s_waitcnt lgkmcnt(" #n ")" ::: "memory")
#define HM_BAR __builtin_amdgcn_s_barrier()
#define HM_SCHED __builtin_amdgcn_sched_barrier(0)
    Unit cur, nxt; int ui = 0;
    if (!S.next(0, cur)) return;
    f32x4 acc[1][2][4][2];
#pragma unroll
    for (int b = 0; b < 2; ++b)
#pragma unroll
        for (int m = 0; m < 4; ++m)
#pragma unroll
            for (int n = 0; n < 2; ++n) acc[0][b][m][n] = (f32x4){0.f, 0.f, 0.f, 0.f};
    bf16x8 At[4][2], B0[2][2], B1[2][2];
    unsigned cA = cur.A, cB = cur.B;
    HM_STAGE3(0, cB, cA);
    if (wr == 1) HM_BAR;
    HM_WAIT_V(0); HM_BAR;
    HM_STAGE3(SLOT, cB + kstep, cA + kstep);
    typename Epi::Pre pre;
    if constexpr (Epi::HAS_PRE) { asm volatile("" ::: "memory"); E.pre(pre, cur, wr, wc, fr, fq); asm volatile("" ::: "memory"); }
    HM_BAR;
    int rs = 0;
    for (;;) {
        const bool has_next = S.next(ui + 1, nxt);
        const unsigned nA = has_next ? nxt.A : cA, nB = has_next ? nxt.B : cB;
        for (int t = 0; t < nt; ++t) {
            const unsigned a2 = (t + 2 < nt) ? cA + (unsigned)(t + 2) * kstep : nA + (unsigned)(t + 2 - nt) * kstep;
            const unsigned b2 = (t + 2 < nt) ? cB + (unsigned)(t + 2) * kstep : nB + (unsigned)(t + 2 - nt) * kstep;
            const int so = rs * SLOT, sn = (rs == 0 ? 2 : rs - 1) * SLOT;
            HM_LDB(B0, so, 0); HM_LDB(B1, so, 1); HM_SCHED; HM_LDA(At, so); HM_STAGE3(sn, b2, a2);
            HM_WAIT_V(6); HM_WAIT_L(0); HM_BAR; HM_MMA(0, At, B0); HM_MMA(1, At, B1); HM_BAR; HM_SCHED;
            rs = rs == 2 ? 0 : rs + 1;
        }
        if (wr == 0) HM_BAR;
        bool keep;
        if constexpr (Epi::HAS_PRE) keep = E.template run<1>(acc, cur, pre, wr, wc, fr, fq); else keep = E.template run<1>(acc, cur, wr, wc, fr, fq);
        if (!has_next) break;
        if (!keep) {
#pragma unroll
            for (int b = 0; b < 2; ++b)
#pragma unroll
                for (int m = 0; m < 4; ++m)
#pragma unroll
                    for (int n = 0; n < 2; ++n) acc[0][b][m][n] = (f32x4){0.f, 0.f, 0.f, 0.f};
        }
        cur = nxt; cA = nA; cB = nB; ++ui;
        if (wr == 1) HM_BAR;
    }
    HM_WAIT_V(0);
    HM_BAR;
#undef HM_STAGE
#undef HM_STAGE3
#undef HM_LDA
#undef HM_LDB
#undef HM_MMA
#undef HM_WAIT_V
#undef HM_WAIT_L
#undef HM_BAR
#undef HM_SCHED
}

struct EpiF32 { static constexpr bool HAS_PRE = false; struct Pre {}; float* O; int ldc;
    template <int NAI> __device__ __forceinline__ bool run(f32x4 (&acc)[NAI][2][4][2], const Unit& u, int wr, int wc, int fr, int fq) const {
        const int row0 = u.pm * (HALF * NAI) + wr * 64 + fr, col0 = u.pn * BM + wc * 32 + 4 * fq;
#pragma unroll
        for (int ai = 0; ai < NAI; ++ai)
#pragma unroll
            for (int m = 0; m < 4; ++m) { float* rp = O + (size_t)(row0 + ai * HALF + m * 16) * ldc + col0;
#pragma unroll
                for (int bj = 0; bj < 2; ++bj)
#pragma unroll
                    for (int n = 0; n < 2; ++n) st16f(rp + bj * HALF + n * 16, acc[ai][bj][m][n]); }
        return false; } };
struct EpiBf16 { static constexpr bool HAS_PRE = false; struct Pre {}; bf16_t* O; int ldc;
    template <int NAI> __device__ __forceinline__ bool run(f32x4 (&acc)[NAI][2][4][2], const Unit& u, int wr, int wc, int fr, int fq) const {
        const int row0 = u.pm * (HALF * NAI) + wr * 64 + fr, col0 = u.pn * BM + wc * 32 + pair16_col(fq);
#pragma unroll
        for (int ai = 0; ai < NAI; ++ai)
#pragma unroll
            for (int m = 0; m < 4; ++m) { bf16_t* rp = O + (size_t)(row0 + ai * HALF + m * 16) * ldc + col0;
#pragma unroll
                for (int bj = 0; bj < 2; ++bj) st16u(rp + bj * HALF, pair16(pk4(acc[ai][bj][m][0]), pk4(acc[ai][bj][m][1]))); }
        return false; } };
struct EpiBf16Probe { bf16_t* O; int ldc;
    template <int NAI> __device__ __forceinline__ bool run(f32x4 (&acc)[2][2][4][2], const Unit& u, int wr, int wc, int fr, int fq) const {
        const int row0 = u.pm * BM + wr * 64 + fr, col0 = (u.pn & 7) * BM + wc * 32 + 4 * fq;
#pragma unroll
        for (int ai = 0; ai < 2; ++ai)
#pragma unroll
            for (int m = 0; m < 4; ++m) { bf16_t* rp = O + (size_t)(row0 + ai * HALF + m * 16) * ldc + col0;
#pragma unroll
                for (int bj = 0; bj < 2; ++bj)
#pragma unroll
                    for (int n = 0; n < 2; ++n) st8(rp + bj * HALF + n * 16, pk4(acc[ai][bj][m][n])); }
        return false; } };
struct EpiSwiGLU { bf16_t* O;
    template <int NAI> __device__ __forceinline__ bool run(f32x4 (&acc)[2][2][4][2], const Unit& u, int wr, int wc, int fr, int fq) const {
        const int row0 = u.pm * BM + wr * 64 + fr;
#pragma unroll
        for (int ai = 0; ai < 2; ++ai)
#pragma unroll
            for (int m = 0; m < 4; ++m) { bf16_t* rp = O + (size_t)(row0 + ai * HALF + m * 16) * DFF;
                u32x2 ob[2];
#pragma unroll
                for (int bj = 0; bj < 2; ++bj) { const f32x4 gg = acc[ai][bj][m][0], uu = acc[ai][bj][m][1]; f32x4 o;
#pragma unroll
                    for (int i = 0; i < 4; ++i) { const float e = __builtin_amdgcn_exp2f(-gg[i] * LOG2E); o[i] = gg[i] * fast_rcp(1.f + e) * uu[i]; }
                    ob[bj] = pk4(o); }
                st16u(rp + 32 * (4 * u.pn + wc) + pair16_col(fq), pair16(ob[0], ob[1])); }
        return false; } };
struct EpiBranch { const unsigned char* G; bf16_t* O;
    static constexpr bool HAS_PRE = true;
    struct Pre { unsigned g[3][2][4][2]; };
    __device__ __forceinline__ void pre(Pre& p, const Unit& u, int wr, int wc, int fr, int fq) const {
        const int row0 = u.pm * HALF + wr * 64 + fr, col0 = u.pn * BM + 64 * wc + 16 * fq;
#pragma unroll
        for (int m = 0; m < 4; ++m) { const unsigned char* gp = G + (unsigned)((row0 + m * 16) * GPITCH + col0);
#pragma unroll
            for (int q = 0; q < 3; ++q) { const u32x4 w = *(const u32x4*)(gp + q * 1024);
                p.g[q][0][m][0] = w.x; p.g[q][0][m][1] = w.y; p.g[q][1][m][0] = w.z; p.g[q][1][m][1] = w.w; } } }
    template <int NAI> __device__ __forceinline__ bool run(f32x4 (&acc)[NAI][2][4][2], const Unit& u, const Pre& p, int wr, int wc, int fr, int fq) const {
        static_assert(NAI == 1, "branch merge: 128-row tiles");
        const int tag = u.tag; if (tag == 2) return true;
        const int row0 = u.pm * HALF + wr * 64 + fr, col0 = u.pn * BM + wc * 32 + 4 * fq;
#pragma unroll
        for (int m = 0; m < 4; ++m) { const unsigned row = (unsigned)(row0 + m * 16);
#pragma unroll
            for (int bj = 0; bj < 2; ++bj) { u32x2 ob[2];
#pragma unroll
                for (int n = 0; n < 2; ++n) {
                    unsigned w0 = tag == 0 ? p.g[0][bj][m][n] : p.g[1][bj][m][n], w1 = tag == 0 ? p.g[1][bj][m][n] : p.g[2][bj][m][n];
                    asm volatile("" : "+v"(w0), "+v"(w1));
                    if (tag == 3) { const f32x4 gc = un_gate4(w1); ob[n] = pk4(acc[0][bj][m][n] * gc); }
                    else { const f32x4 g0 = un_gate4(w0), g1 = un_gate4(w1); f32x4 r;
#pragma unroll
                        for (int i = 0; i < 4; ++i) r[i] = g0[i] * fast_rcp(g1[i]);
                        acc[0][bj][m][n] = acc[0][bj][m][n] * r; }
                    __builtin_amdgcn_sched_barrier(0); }
                if (tag == 3) st16u(O + row * DM + u.pn * BM + wc * 32 + bj * HALF + pair16_col(fq), pair16(ob[0], ob[1])); } }
        return tag != 3; } };
typedef GAS unsigned gu32_t;
struct EpiRow { static constexpr bool HAS_PRE = false; struct Pre {}; GAS unsigned char* ws; GAS float* out; const float* x0; const float* x1; const float* npre; const float* npost; LAS unsigned char* lds; int l, which;
    template <int NAI> __device__ __forceinline__ bool run(f32x4 (&acc)[NAI][2][4][2], const Unit& u, int wr, int wc, int fr, int fq) const {
        static_assert(NAI == 1, "fused row epilogue: 128-row tiles only");
        const int lane = fq * 16 + fr, wid = wr * 4 + wc, tid = wid * 64 + lane;
        unsigned char* const wsg = (unsigned char*)ws; float* const X = (float*)out;
        const float* mod = (const float*)(wsg + WS_MOD); bf16_t* const H = (bf16_t*)(wsg + WS_H);
        bf16_t* const XR = (bf16_t*)(wsg + (which == 1 ? WS_AB : WS_MB)); const int xrp = which == 1 ? DFF : DM;
        bf16_t* const XW = (bf16_t*)(wsg + (which == 1 ? WS_MB : WS_AB)); const int xwp = which == 1 ? DM : DFF;
        LAS float* P = (LAS float*)(lds + EXCH_OFF); LAS float* S = P + 512;
        const int pm = u.pm, pn = u.pn, row0 = pm * 128; const int ci = row0 < NCTX ? 0 : 1 + ((row0 - NCTX) >> 10);
        int lh = l, wh = 1; if (which == 2) { lh = l + 1; wh = 0; }
        const bool has_h = lh < DEPTH; const int lhc = has_h ? lh : 0;
        gu32_t* cnt0 = (gu32_t*)(ws + WS_CTL) + CW_XCNT + ((l * 2 + (which - 1)) * 2) * 1024 + pm * 16;
        GAS float* slots = (GAS float*)(ws + WS_XS);
        const int colw = pn * 256 + wc * 32 + 4 * fq;
        auto stats = [&](int e) {
#pragma unroll
            for (int m = 0; m < 4; ++m) { float sq = 0.f;
#pragma unroll
                for (int bj = 0; bj < 2; ++bj)
#pragma unroll
                    for (int n = 0; n < 2; ++n) { const f32x4 v = acc[0][bj][m][n]; sq += (v[0] * v[0] + v[1] * v[1]) + (v[2] * v[2] + v[3] * v[3]); }
                sq += shx(sq, 16, lane); sq += shx(sq, 32, lane);
                if (fq == 0) P[(wr * 64 + m * 16 + fr) * 4 + wc] = sq; }
            asm volatile("s_waitcnt lgkmcnt(0)" ::: "memory"); __builtin_amdgcn_s_barrier(); asm volatile("" ::: "memory");
            if (tid < 128) { const float t = (P[tid * 4 + 0] + P[tid * 4 + 1]) + (P[tid * 4 + 2] + P[tid * 4 + 3]);
                __hip_atomic_store(slots + ((size_t)e * NTOK + row0 + tid) * 4 + pn, t, __ATOMIC_RELAXED, __HIP_MEMORY_SCOPE_AGENT); }
            asm volatile("s_waitcnt vmcnt(0)" ::: "memory");
            if (tid < 128 && lane == 0) __hip_atomic_fetch_add(cnt0 + e * 1024, 1u, __ATOMIC_RELAXED, __HIP_MEMORY_SCOPE_AGENT);
            if (wid == 0) {
                for (int sp = 0; sp < 400000; ++sp) { if ((unsigned)__builtin_amdgcn_readfirstlane(__hip_atomic_load(cnt0 + e * 1024, __ATOMIC_RELAXED, __HIP_MEMORY_SCOPE_AGENT)) >= 8u) break; __builtin_amdgcn_s_sleep(2); }
                asm volatile("" ::: "memory");
            }
            asm volatile("s_waitcnt vmcnt(0) lgkmcnt(0)" ::: "memory"); __builtin_amdgcn_s_barrier(); asm volatile("" ::: "memory");
            if (tid < 128) { const GAS float* sp4 = slots + ((size_t)e * NTOK + row0 + tid) * 4; float tot = 0.f;
#pragma unroll
                for (int t = 0; t < 4; ++t) tot += __hip_atomic_load(sp4 + t, __ATOMIC_RELAXED, __HIP_MEMORY_SCOPE_AGENT);
                S[tid] = 1.0f / sqrtf(tot * (1.0f / DM) + NORM_EPS); }
            asm volatile("s_waitcnt lgkmcnt(0)" ::: "memory"); __builtin_amdgcn_s_barrier(); asm volatile("" ::: "memory");
        };
        {
            f32x4 xv[4][2][2];
#pragma unroll
            for (int m = 0; m < 4; ++m) { const int row = row0 + wr * 64 + m * 16 + fr;
                if (l == 0 && which == 1) { const float* xs = row < NCTX ? x0 + (size_t)row * DM : x1 + (size_t)(row - NCTX) * DM;
#pragma unroll
                    for (int bj = 0; bj < 2; ++bj)
#pragma unroll
                        for (int n = 0; n < 2; ++n) xv[m][bj][n] = *(const f32x4*)(xs + colw + 128 * bj + 16 * n); }
                else { const bf16_t* xs = XR + (size_t)row * xrp + pn * 256 + wc * 64 + fq * 16;
#pragma unroll
                    for (int bj = 0; bj < 2; ++bj) { const u32x4 w = *(const u32x4*)(xs + 8 * bj); u32x2 a, b; a.x = w.x; a.y = w.y; b.x = w.z; b.y = w.w; xv[m][bj][0] = bf4_to_f32(a); xv[m][bj][1] = bf4_to_f32(b); } } }
            const float* gate = mod + (size_t)(l * 5 + ci) * 6144 + (which == 1 ? 2048 : 5120); const float* gpo = npost + (size_t)(l * 2 + (which - 1)) * DM;
            f32x4 gg[2][2];
#pragma unroll
            for (int bj = 0; bj < 2; ++bj)
#pragma unroll
                for (int n = 0; n < 2; ++n) { const int c0 = colw + 128 * bj + 16 * n; gg[bj][n] = *(const f32x4*)(gpo + c0) * *(const f32x4*)(gate + c0); }
            stats(0);
#pragma unroll
            for (int bj = 0; bj < 2; ++bj)
#pragma unroll
                for (int m = 0; m < 4; ++m) { const int rl = wr * 64 + m * 16 + fr; const float rstd = S[rl];
                    const f32x4 xn0 = xv[m][bj][0] + gg[bj][0] * (acc[0][bj][m][0] * rstd), xn1 = xv[m][bj][1] + gg[bj][1] * (acc[0][bj][m][1] * rstd);
                    acc[0][bj][m][0] = xn0; acc[0][bj][m][1] = xn1;
                    if (has_h) { const u32x2 a = pk4(xn0), b = pk4(xn1); u32x4 o; o.x = a.x; o.y = a.y; o.z = b.x; o.w = b.y; st16u(XW + (size_t)(row0 + rl) * xwp + pn * 256 + wc * 64 + fq * 16 + 8 * bj, o); }
                    else { float* xp = X + (size_t)(row0 + rl) * DM + colw + 128 * bj; *(GAS f32x4*)xp = xn0; *(GAS f32x4*)(xp + 16) = xn1; } }
        }
        if (has_h) {
            const float* gpr = npre + (size_t)(lhc * 2 + wh) * DM; const float* mm = mod + (size_t)(lhc * 5 + ci) * 6144 + (wh ? 3072 : 0);
            f32x4 gs[2][2], sh[2][2];
#pragma unroll
            for (int bj = 0; bj < 2; ++bj)
#pragma unroll
                for (int n = 0; n < 2; ++n) { const int c0 = colw + 128 * bj + 16 * n; gs[bj][n] = *(const f32x4*)(gpr + c0) * (1.0f + *(const f32x4*)(mm + 1024 + c0)); sh[bj][n] = *(const f32x4*)(mm + c0); }
            stats(1);
#pragma unroll
            for (int bj = 0; bj < 2; ++bj)
#pragma unroll
                for (int m = 0; m < 4; ++m) { const int rl = wr * 64 + m * 16 + fr; const float rstd = S[rl];
                    st16u(H + (size_t)(row0 + rl) * DM + pn * 256 + wc * 32 + 128 * bj + pair16_col(fq),
                          pair16(pk4((acc[0][bj][m][0] * rstd) * gs[bj][0] + sh[bj][0]), pk4((acc[0][bj][m][1] * rstd) * gs[bj][1] + sh[bj][1]))); }
        }
        return false; } };
struct EpiIn { GAS unsigned char* ws; GAS float* out; int layer;
    __device__ __forceinline__ void tstore(f32x4 (&acc)[2][2][4][2], int bj, bf16_t* buf, int RB, int cvb, float* fo, int fld, int pm, int wr, int wc, int fr, int fq) const {
        const bool lat = pm >= 16; const int T = lat ? 1024 : 256;
#pragma unroll
        for (int n = 0; n < 2; ++n) { const int cv = cvb + 32 * wc + 16 * n + 4 * fq;
#pragma unroll
            for (int ai = 0; ai < 2; ++ai)
#pragma unroll
                for (int m = 0; m < 4; ++m) { int tok = pm * 256 + ai * 128 + wr * 64 + m * 16 + fr; asm volatile("" : "+v"(tok)); const f32x4 v = acc[ai][bj][m][n];
                    int bb, t; if (lat) { bb = (tok - NCTX) >> 10; t = (tok - NCTX) & 1023; } else { bb = tok >> 8; t = tok & 255; }
                    bf16_t* p = buf + (unsigned)((lat ? RB * 4096 : 0) + (bb * RB + cv) * T + t);
#pragma unroll
                    for (int i = 0; i < 4; ++i) st2(p + i * T, f2bf(v[i]));
                    if (!lat && fo) __builtin_nontemporal_store(v, (GAS f32x4*)(fo + (unsigned)(((bb * 2 + layer) * 256 + t) * fld + cv))); } } }
    __device__ __forceinline__ void nstore(f32x4 (&acc)[2][2][4][2], int bj, bf16_t* buf, int ld, int cb, float sc, float* fo, int pm, int wr, int wc, int fr, int fq) const {
        const bool lat = pm >= 16;
        const int colp = cb + 32 * wc + ((fq & 1) ? 16 + 4 * (fq - 1) : 4 * fq);
#pragma unroll
        for (int ai = 0; ai < 2; ++ai)
#pragma unroll
            for (int m = 0; m < 4; ++m) { int tok = pm * 256 + ai * 128 + wr * 64 + m * 16 + fr; asm volatile("" : "+v"(tok)); const f32x4 v0 = acc[ai][bj][m][0], v1 = acc[ai][bj][m][1];
                const u32x2 a = pk4(v0 * sc), b = pk4(v1 * sc);
                const auto rx = __builtin_amdgcn_permlane16_swap(a.x, b.x, false, false); const auto ry = __builtin_amdgcn_permlane16_swap(a.y, b.y, false, false);
                u32x4 o; o.x = rx[0]; o.y = ry[0]; o.z = rx[1]; o.w = ry[1];
                st16u(buf + (unsigned)(tok * ld + colp), o);
                if (!lat && fo) { const int bb = tok >> 8, t = tok & 255; float* fp = fo + (unsigned)(((bb * 2 + layer) * 256 + t) * ld + cb + 32 * wc + 4 * fq);
                    __builtin_nontemporal_store(v0, (GAS f32x4*)fp); __builtin_nontemporal_store(v1, (GAS f32x4*)(fp + 16)); } } }
    template <int NAI> __device__ __forceinline__ bool run(f32x4 (&acc)[2][2][4][2], const Unit& u, int wr, int wc, int fr, int fq) const {
        asm volatile("" : "+v"(fr), "+v"(fq));
        unsigned char* const wsg = (unsigned char*)ws; float* const outg = (float*)out;
        bf16_t* const Qa = (bf16_t*)(wsg + WS_QA); bf16_t* const Ka = (bf16_t*)(wsg + WS_KA); bf16_t* const VaT = (bf16_t*)(wsg + WS_VAT); bf16_t* const Qb = (bf16_t*)(wsg + WS_QB);
        bf16_t* const Kb = (bf16_t*)(wsg + WS_KB); bf16_t* const VbT = (bf16_t*)(wsg + WS_VBT); bf16_t* const UT = (bf16_t*)(wsg + WS_UT); unsigned char* const G = wsg + WS_G;
        const float* const ropec = (const float*)(wsg + WS_ROPEC); const float* const ropes = (const float*)(wsg + WS_ROPES);
        const int pm = u.pm; const bool lat = pm >= 16;
        if (u.pn >= 11) {
            const int gcol = ((u.pn - 11) >> 2) * 1024 + ((u.pn - 11) & 3) * 256 + 64 * wc + 16 * fq;
#pragma unroll
            for (int ai = 0; ai < 2; ++ai)
#pragma unroll
                for (int m = 0; m < 4; ++m) { int tok = pm * 256 + ai * 128 + wr * 64 + m * 16 + fr; asm volatile("" : "+v"(tok)); u32x4 o;
#pragma unroll
                    for (int bj = 0; bj < 2; ++bj)
#pragma unroll
                        for (int n = 0; n < 2; ++n) { f32x4 g;
#pragma unroll
                            for (int i = 0; i < 4; ++i) g[i] = sigmoidf_(acc[ai][bj][m][n][i]);
                            o[2 * bj + n] = pk_gate4(g); }
                    st16u(G + (unsigned)(tok * GPITCH + gcol), o); __builtin_amdgcn_sched_barrier(0); }
            return false;
        }
#pragma unroll
        for (int bj = 0; bj < 2; ++bj) {
            const int cb = u.pn * 256 + bj * 128;
            if (cb < 640) {
                const bool isq = cb < 512; const int head = ((isq ? cb : cb - 512) >> 6) + (wc >> 1); const int dlo = 16 * (wc & 1) + 4 * fq;
#pragma unroll
                for (int ai = 0; ai < 2; ++ai) {
                    f32x4 rc[4], rs[4];
                    if (lat) {
#pragma unroll
                        for (int m = 0; m < 4; ++m) { int tok = pm * 256 + ai * 128 + wr * 64 + m * 16 + fr; asm volatile("" : "+v"(tok)); const int t = (tok - NCTX) & 1023;
                            rc[m] = *(const f32x4*)(ropec + t * 32 + dlo); rs[m] = *(const f32x4*)(ropes + t * 32 + dlo); } }
#pragma unroll
                    for (int m = 0; m < 4; ++m) { int tok = pm * 256 + ai * 128 + wr * 64 + m * 16 + fr; asm volatile("" : "+v"(tok)); const f32x4 v0 = acc[ai][bj][m][0], v1 = acc[ai][bj][m][1]; f32x4 o0 = v0, o1 = v1;
                        if (lat) { const f32x4 c = rc[m], s = rs[m]; o0 = v0 * c - v1 * s; o1 = v0 * s + v1 * c; }
                        const int dp = 16 * (wc & 1) + ((fq & 1) ? 32 + 4 * (fq - 1) : 4 * fq);
                        if (isq) { st16u(Qa + (unsigned)(tok * 512 + head * 64 + dp), pair16(pk4(o0 * QSCALE), pk4(o1 * QSCALE))); }
                        else { st16u(Ka + (unsigned)(tok * 128 + head * 64 + dp), pair16(pk4(o0), pk4(o1)));
                            if (!lat) { const int bb = tok >> 8, t = tok & 255; float* fo = outg + (unsigned)(OUT_NAK + ((bb * 2 + layer) * 256 + t) * 128 + head * 64 + dlo); __builtin_nontemporal_store(o0, (GAS f32x4*)fo); __builtin_nontemporal_store(o1, (GAS f32x4*)(fo + 32)); } } } }
            }
            else if (cb < 768)  tstore(acc, bj, VaT, 128, cb - 640, outg + OUT_NAV, 128, pm, wr, wc, fr, fq);
            else if (cb < 1280) nstore(acc, bj, Qb, 512, cb - 768, QSCALE, nullptr, pm, wr, wc, fr, fq);
            else if (cb < 1792) nstore(acc, bj, Kb, 512, cb - 1280, 1.f, outg + OUT_NBK, pm, wr, wc, fr, fq);
            else if (cb < 2304) tstore(acc, bj, VbT, 512, cb - 1792, outg + OUT_NBV, 512, pm, wr, wc, fr, fq);
            else if (cb < 2816) tstore(acc, bj, UT, 512, cb - 2304, nullptr, 0, pm, wr, wc, fr, fq);
        }
        return false; } };
}

typedef GAS unsigned gu32;
#define RLX_AGENT __ATOMIC_RELAXED, __HIP_MEMORY_SCOPE_AGENT
#define XB_TMO      128
#define XB_XCNT(j)  (256  + 64 * (j))
#define XB_XSUB(j)  (1280 + 64 * (j))
#define XB_XGEN(j)  (2304 + 64 * (j))
#define XB_TOP      3328
#define XB_TOPGEN   3392
#define XCD_BAR_WORDS 3456
#define XB_LSUB(j)  (3520 + 64 * (j))
#define XB_LGEN(j)  (4096 + 64 * (j))
#define XB_PSUB(j)  (4608 + 64 * (j))
#define XB_PGEN(j)  (5120 + 64 * (j))
#define XB_PTOP(j)  (5632 + 64 * (j))
#define XB_PTGEN(j) (5888 + 64 * (j))
#define XB_SPIN_CAP (1u << 18)
__device__ __forceinline__ unsigned xb_ld(unsigned* p)              { return __hip_atomic_load(p, __ATOMIC_RELAXED, __HIP_MEMORY_SCOPE_AGENT); }
__device__ __forceinline__ unsigned xb_add(unsigned* p, unsigned v) { return __hip_atomic_fetch_add(p, v, __ATOMIC_RELAXED, __HIP_MEMORY_SCOPE_AGENT); }
__device__ __forceinline__ unsigned xb_xcc_id() { return (unsigned)__builtin_amdgcn_s_getreg((3 << 11) | 20) & 0xFu; }
#define XB_SPIN(cond, bar) do { unsigned _sp = 0; while (cond) { __builtin_amdgcn_s_sleep(1); \
    if ((++_sp & 255u) == 0u) { if (xb_ld(&(bar)[XB_TMO])) break; if (_sp > XB_SPIN_CAP) { atomicAdd(&(bar)[XB_TMO], 1u); break; } } } } while (0)
struct XcdBarrier { unsigned* bar; unsigned x; volatile LAS unsigned* st; };
__device__ __forceinline__ XcdBarrier xcd_barrier_post(unsigned* bar, volatile LAS unsigned* st) {
    XcdBarrier b; b.bar = bar; b.x = xb_xcc_id(); b.st = st;
    if (threadIdx.x == 0) { const unsigned r = xb_add(&bar[XB_XCNT(b.x)], 1u); st[3] = r; st[4] = b.x; }
    return b;
}
__device__ __forceinline__ void xcd_barrier_complete(unsigned* bar, unsigned x, unsigned& nloc, unsigned& nx, unsigned& uni) {
    const unsigned G = gridDim.x * gridDim.y * gridDim.z;
    unsigned sum, cnt, mine, ok, sp = 0u;
    for (;;) {
        sum = 0u; cnt = 0u; mine = 0u; ok = 1u;
#pragma unroll
        for (unsigned j = 0; j < 16; ++j) { const unsigned c = xb_ld(&bar[XB_XCNT(j)]); sum += c; cnt += (c > 0u) ? 1u : 0u; mine = (j == x) ? c : mine; ok &= (c == (j < 8u ? 32u : 0u)) ? 1u : 0u; }
        if (sum == G) break;
        __builtin_amdgcn_s_sleep(1);
        if ((++sp & 255u) == 0u) { if (xb_ld(&bar[XB_TMO])) break; if (sp > XB_SPIN_CAP) { atomicAdd(&bar[XB_TMO], 1u); break; } }
    }
    nloc = mine > 0u ? mine : 1u; nx = cnt > 0u ? cnt : 1u; uni = (ok != 0u && sum == G && G == 256u) ? 1u : 0u;
}
__device__ __forceinline__ void xcd_barrier(const XcdBarrier& b) {
    asm volatile("s_waitcnt vmcnt(0)" ::: "memory");
    __syncthreads();
    if (threadIdx.x == 0) {
        unsigned* bar = b.bar; asm volatile("" : "+s"(bar));
        __builtin_amdgcn_s_waitcnt(0);
        asm volatile("buffer_inv sc1" ::: "memory");
        unsigned nloc = b.st[0], nx = b.st[1];
        if (nloc == 0u) { unsigned uni; xcd_barrier_complete(bar, b.x, nloc, nx, uni); b.st[0] = nloc; b.st[1] = nx; b.st[2] = uni; }
        const unsigned old = xb_add(&bar[XB_XSUB(b.x)], 1u);
        const unsigned gen = old / nloc;
        if (old + 1u == (gen + 1u) * nloc) {
            __builtin_amdgcn_fence(__ATOMIC_RELEASE, "agent");
            asm volatile("s_waitcnt vmcnt(0)" ::: "memory");
            const unsigned og = xb_add(&bar[XB_TOP], 1u);
            const unsigned tg = og / nx;
            if (og + 1u == (tg + 1u) * nx) xb_add(&bar[XB_TOPGEN], 1u);
            else XB_SPIN(xb_ld(&bar[XB_TOPGEN]) == tg, bar);
            xb_add(&bar[XB_XGEN(b.x)], 1u);
            asm volatile("s_waitcnt vmcnt(0)" ::: "memory");
        } else {
            XB_SPIN(xb_ld(&bar[XB_XGEN(b.x)]) == gen, bar);
            asm volatile("s_waitcnt vmcnt(0)" ::: "memory");
        }
    }
    __syncthreads();
}

__device__ __forceinline__ void xcd_local_barrier(const XcdBarrier& b) {
    asm volatile("s_waitcnt vmcnt(0)" ::: "memory");
    __syncthreads();
    if (threadIdx.x == 0) {
        unsigned* bar = b.bar; asm volatile("" : "+s"(bar));
        const unsigned x = b.st[4];
        __builtin_amdgcn_s_waitcnt(0);
        asm volatile("buffer_inv sc1" ::: "memory");
        const unsigned old = xb_add(&bar[XB_LSUB(x)], 1u), gen = old >> 5;
        if ((old & 31u) == 31u) (void)xb_add(&bar[XB_LGEN(x)], 1u);
        else XB_SPIN(xb_ld(&bar[XB_LGEN(x)]) == gen, bar);
        asm volatile("s_waitcnt vmcnt(0)" ::: "memory");
    }
    __syncthreads();
}

__device__ __forceinline__ void xcd_pair_barrier(const XcdBarrier& b) {
    asm volatile("s_waitcnt vmcnt(0)" ::: "memory");
    __syncthreads();
    if (threadIdx.x == 0) {
        unsigned* bar = b.bar; asm volatile("" : "+s"(bar));
        const unsigned x = b.st[4], pr = x >> 1;
        __builtin_amdgcn_s_waitcnt(0);
        asm volatile("buffer_inv sc1" ::: "memory");
        const unsigned old = xb_add(&bar[XB_PSUB(x)], 1u), gen = old >> 5;
        if ((old & 31u) == 31u) {
            __builtin_amdgcn_fence(__ATOMIC_RELEASE, "agent");
            asm volatile("s_waitcnt vmcnt(0)" ::: "memory");
            const unsigned og = xb_add(&bar[XB_PTOP(pr)], 1u), tg = og >> 1;
            if ((og & 1u) == 1u) (void)xb_add(&bar[XB_PTGEN(pr)], 1u);
            else XB_SPIN(xb_ld(&bar[XB_PTGEN(pr)]) == tg, bar);
            (void)xb_add(&bar[XB_PGEN(x)], 1u);
        } else XB_SPIN(xb_ld(&bar[XB_PGEN(x)]) == gen, bar);
        asm volatile("s_waitcnt vmcnt(0)" ::: "memory");
    }
    __syncthreads();
}

struct Args { const float* in[19]; float* out; unsigned char* ws; int ph_lo, ph_hi; };
struct Frame {
    LAS unsigned char* lds; int vcu, G, lm;
    GAS float* out; GAS unsigned char* ws;
};
typedef const __attribute__((address_space(4))) Args* ArgsP;
#define INP(k) ((const float*)(const GAS float*)(args->in[k]))
#define WSP(T, off) ((T*)(GAS T*)(F.ws + (off)))

__device__ __forceinline__ int rowmap(int mode, int n) {
    if (mode == 1) { if (n < 640) { const int d = n & 63; return (n & ~63) + 32 * ((d & 31) >> 4) + 16 * (d >> 5) + (d & 15); } return n; }
    if (mode == 2) { const int nn = n >= DFF ? 1 : 0, jj = n - nn * DFF, q = jj >> 4, pq = (q & ~7) + 4 * (q & 1) + ((q & 7) >> 1);
        return 32 * pq + 16 * nn + (jj & 15); }
    return n;
}
__device__ __forceinline__ void p0_transpose_item(const float* W, int K, int N, bf16_t* WT, int mode, int item, int lane) {
    const int nblk = N >> 6, kb = item / nblk, nb = item - kb * nblk, g = lane >> 4, c = lane & 15;
    const float* src = W + (size_t)(kb * 32 + 8 * g) * N + nb * 64 + 4 * c;
    f32x4 v[8];
#pragma unroll
    for (int j = 0; j < 8; ++j) v[j] = __builtin_nontemporal_load((const f32x4*)(src + (size_t)j * N));
    bf16_t* dst = WT + kb * 32 + 8 * g;
#pragma unroll
    for (int e = 0; e < 4; ++e) { u32x4 o; o.x = pk2(v[0][e], v[1][e]); o.y = pk2(v[2][e], v[3][e]); o.z = pk2(v[4][e], v[5][e]); o.w = pk2(v[6][e], v[7][e]);
        st16u(dst + (size_t)rowmap(mode, nb * 64 + 4 * c + e) * K, o); }
}
struct TItem { const float* W; bf16_t* WT; int K, N, mode, kb, nb; };
__device__ __forceinline__ void titem_load(const TItem& t, f32x4 (&v)[8], int lane) {
    const float* src = t.W + (size_t)(t.kb * 32 + 8 * (lane >> 4)) * t.N + t.nb * 64 + 4 * (lane & 15);
#pragma unroll
    for (int j = 0; j < 8; ++j) v[j] = __builtin_nontemporal_load((const f32x4*)(src + (size_t)j * t.N));
}
__device__ __forceinline__ void titem_store(const TItem& t, const f32x4 (&v)[8], int lane) {
    bf16_t* dst = t.WT + t.kb * 32 + 8 * (lane >> 4);
#pragma unroll
    for (int e = 0; e < 4; ++e) { u32x4 o; o.x = pk2(v[0][e], v[1][e]); o.y = pk2(v[2][e], v[3][e]); o.z = pk2(v[4][e], v[5][e]); o.w = pk2(v[6][e], v[7][e]);
        *(u32x4*)(dst + (size_t)rowmap(t.mode, t.nb * 64 + 4 * (lane & 15) + e) * t.K) = o; }
}
__device__ __forceinline__ void p0_fold_item(const float* Wc, bf16_t* WtBr, int item, int lane) {
    const int ct = item & 3, nt = (item >> 2) & 31, g = (item >> 7) & 3, cs = item >> 9;
    const int r = lane & 31, hh = lane >> 5, c = ct * 32 + r;
    const float* ap = Wc + (size_t)(g * 128 + hh) * DM + nt * 32 + r;
    f32x16 acc;
#pragma unroll
    for (int i = 0; i < 16; ++i) acc[i] = 0.f;
#pragma unroll 8
    for (int st = 0; st < 64; ++st) {
        const float a = ap[(size_t)(2 * st) * DM];
        float sv, cv; sincospif((float)(((2 * st + hh) * c) & 127) * (1.0f / 64.0f), &sv, &cv);
        const float bq = (cs ? -sv : cv) * 0.08838834764831845f;
        acc = __builtin_amdgcn_mfma_f32_32x32x2f32(a, bq, acc, 0, 0, 0);
    }
    bf16_t* o = WtBr + (size_t)(2 + cs) * DM * 512 + g * 128 + c;
#pragma unroll
    for (int i = 0; i < 16; ++i) st2(o + (size_t)(nt * 32 + (i & 3) + 8 * (i >> 2) + 4 * hh) * 512, f2bf(acc[i]));
}
constexpr int P0W_I_IN = 32 * (DIN / 64), P0W_I_BR = 16 * 16, P0W_I_OUT = 32 * 16, P0W_I_F1 = 32 * (DFF2 / 64), P0W_I_F2 = (DFF / 32) * 16;
constexpr int P0W_NIT = P0W_I_IN + 2 * P0W_I_BR + P0W_I_OUT + P0W_I_F1 + P0W_I_F2;
__device__ __forceinline__ void p0_weight_items(Frame& F, ArgsP args, int lo, int hi, int w, int nw, int lane, bool deep = false) {
    constexpr int I_IN = P0W_I_IN, I_BR = P0W_I_BR, I_OUT = P0W_I_OUT, I_F1 = P0W_I_F1, NIT = P0W_NIT;
    auto decode = [&](int it) -> TItem {
        const int l = it >= NIT ? 1 : 0; int r = it - l * NIT; unsigned char* wl = (unsigned char*)F.ws + WS_W + (size_t)l * W_LAYER; TItem t;
        if (r < I_IN) { t.W = INP(12) + (size_t)l * DM * DIN; t.K = DM; t.N = DIN; t.WT = (bf16_t*)(wl + W_IN); t.mode = 1; }
        else if ((r -= I_IN) < I_BR) { t.W = INP(15) + (size_t)(l * 3 + 0) * 512 * DM; t.K = 512; t.N = DM; t.WT = (bf16_t*)(wl + W_BR); t.mode = 0; }
        else if ((r -= I_BR) < I_BR) { t.W = INP(15) + (size_t)(l * 3 + 1) * 512 * DM; t.K = 512; t.N = DM; t.WT = (bf16_t*)(wl + W_BR) + (size_t)DM * 512; t.mode = 0; }
        else if ((r -= I_BR) < I_OUT) { t.W = INP(16) + (size_t)l * DM * DM; t.K = DM; t.N = DM; t.WT = (bf16_t*)(wl + W_OUT); t.mode = 0; }
        else if ((r -= I_OUT) < I_F1) { t.W = INP(17) + (size_t)l * DM * DFF2; t.K = DM; t.N = DFF2; t.WT = (bf16_t*)(wl + W_F1); t.mode = 2; }
        else { r -= I_F1; t.W = INP(18) + (size_t)l * DFF * DM; t.K = DFF; t.N = DM; t.WT = (bf16_t*)(wl + W_F2); t.mode = 0; }
        const int nblk = t.N >> 6; t.kb = r / nblk; t.nb = r - t.kb * nblk; return t; };
    if (deep) {
        for (int it = lo + w; it < hi; it += 4 * nw) {
            const bool h1 = it + nw < hi, h2 = it + 2 * nw < hi, h3 = it + 3 * nw < hi;
            const TItem ta = decode(it), tb = decode(h1 ? it + nw : it), tc = decode(h2 ? it + 2 * nw : it), td = decode(h3 ? it + 3 * nw : it);
            f32x4 va[8], vb[8], vc[8], vd[8];
            titem_load(ta, va, lane); if (h1) titem_load(tb, vb, lane); if (h2) titem_load(tc, vc, lane); if (h3) titem_load(td, vd, lane);
            titem_store(ta, va, lane); if (h1) titem_store(tb, vb, lane); if (h2) titem_store(tc, vc, lane); if (h3) titem_store(td, vd, lane);
        }
        return;
    }
    for (int it = lo + w; it < hi; it += 2 * nw) {
        const bool two = it + nw < hi; const TItem ta = decode(it), tb = decode(two ? it + nw : it);
        f32x4 va[8], vb[8];
        titem_load(ta, va, lane); if (two) titem_load(tb, vb, lane);
        titem_store(ta, va, lane); if (two) titem_store(tb, vb, lane);
    }
}
constexpr int P0W_KEEP = 1280;
constexpr int P0W_DEFER_A = 2048;
__device__ __forceinline__ void p0_prologue(Frame& F, ArgsP args) {
    asm volatile("" : "+s"(args));
    const int tid = opaque_tid(), lane = tid & 63, wave = __builtin_amdgcn_readfirstlane(tid >> 6);
    const int gw = F.vcu * NWAVES + wave, NGW = F.G * NWAVES;
#if PREREAD
    {
        const int szs[6] = {2 * DM * 6144, 2 * DM * DIN, 2 * 3 * 512 * DM, 2 * DM * DM, 2 * DM * DFF2, 2 * DFF * DM};
        const int idx[6] = {8, 12, 15, 16, 17, 18};
        float accs = 0.f;
#pragma unroll
        for (int a = 0; a < 6; ++a) { const f32x4* src = (const f32x4*)(a == 0 ? INP(8) : a == 1 ? INP(12) : a == 2 ? INP(15) : a == 3 ? INP(16) : a == 4 ? INP(17) : INP(18)); const int n4 = szs[a] / 4;
            for (int i = gw * 256 + lane; i < n4; i += NGW * 256) { f32x4 t0 = src[i], t1 = i + 64 < n4 ? src[i + 64] : t0, t2 = i + 128 < n4 ? src[i + 128] : t0, t3 = i + 192 < n4 ? src[i + 192] : t0; accs += t0[0] + t1[1] + t2[2] + t3[3]; } }
        if (accs == 123.456f) WSP(float, WS_MOD)[0] = accs;
    }
#endif
    {
        LAS float* sc = (LAS float*)F.lds;
        LAS float* part = (LAS float*)(F.lds + 32768);
        for (int i = tid; i < 5 * 1024; i += NWAVES * 64) { const int ci = i >> 10, k = i & 1023; const float v = ci == 0 ? INP(7)[k] : INP(6)[(ci - 1) * 1024 + k]; sc[i] = v * sigmoidf_(v); }
        __syncthreads();
        for (int item = F.vcu; item < 192; item += F.G) {
            const int l = item / 96, j0 = (item % 96) * 64; const int kb = wave * 128; const float* W = INP(8) + (size_t)l * DM * 6144 + (size_t)kb * 6144 + j0 + lane;
            float a[5] = {0.f, 0.f, 0.f, 0.f, 0.f};
            for (int k0 = 0; k0 < 128; k0 += 32) { float w[32];
#pragma unroll
                for (int u = 0; u < 32; ++u) w[u] = __builtin_nontemporal_load(W + (size_t)(k0 + u) * 6144);
#pragma unroll
                for (int u = 0; u < 32; ++u)
#pragma unroll
                    for (int ci = 0; ci < 5; ++ci) a[ci] += sc[ci * 1024 + kb + k0 + u] * w[u]; }
#pragma unroll
            for (int ci = 0; ci < 5; ++ci) part[(wave * 5 + ci) * 64 + lane] = a[ci];
            __syncthreads();
            if (wave < 5) { float sm = 0.f;
#pragma unroll
                for (int w = 0; w < 8; ++w) sm += part[(w * 5 + wave) * 64 + lane];
                __hip_atomic_store((GAS float*)(WSP(float, WS_MOD) + (size_t)(l * 5 + wave) * 6144 + j0 + lane), sm + INP(9)[l * 6144 + j0 + lane], __ATOMIC_RELAXED, __HIP_MEMORY_SCOPE_AGENT); }
            asm volatile("s_waitcnt vmcnt(0)" ::: "memory");
            __syncthreads();
            if (tid == 0) __hip_atomic_fetch_add((GAS unsigned*)(F.ws + WS_CTL) + CW_MODCNT, 1u, __ATOMIC_RELAXED, __HIP_MEMORY_SCOPE_AGENT);
        }
    }
    {
        p0_weight_items(F, args, 0, P0W_NIT + P0W_KEEP, gw, NGW, lane);
        for (int it = gw; it < 2048; it += NGW) { const int l = it >> 10; p0_fold_item(INP(15) + (size_t)(l * 3 + 2) * 512 * DM, (bf16_t*)((unsigned char*)F.ws + WS_W + (size_t)l * W_LAYER + W_BR), it & 1023, lane); }
    }
    for (int it = gw; it < 128 + 512; it += NGW) {
        if (it < 128) { const int bl = it >> 4; p0_transpose_item(INP(3) + (size_t)bl * 256 * 128, 256, 128, WSP(bf16_t, WS_CVAT) + (size_t)bl * 128 * 256, 0, it & 15, lane); }
        else { const int r = it - 128, bl = r >> 6; p0_transpose_item(INP(5) + (size_t)bl * 256 * 512, 256, 512, WSP(bf16_t, WS_CVBT) + (size_t)bl * 512 * 256, 0, r & 63, lane); }
    }
    {
        const int gt = gw * 64 + lane, NT = NGW * 64;
        GAS bf16_t* dc = (GAS bf16_t*)WSP(bf16_t, WS_DFTC); GAS bf16_t* dl = (GAS bf16_t*)WSP(bf16_t, WS_DFTL);
        for (int i = gt; i < 65536; i += NT) { const int a = i >> 8, b = i & 255; float sv, cv; sincospif((float)((a * b) & 255) * (1.0f / 128.0f), &sv, &cv); dc[i] = (bf16_t)f2bf(cv * 0.0625f); dc[65536 + i] = (bf16_t)f2bf(sv * 0.0625f); }
        for (int i = gt; i < 1048576; i += NT) { const int a = i >> 10, b = i & 1023; float sv, cv; sincospif((float)((a * b) & 1023) * (1.0f / 512.0f), &sv, &cv); dl[i] = (bf16_t)f2bf(cv * 0.03125f); dl[1048576 + i] = (bf16_t)f2bf(sv * 0.03125f); }
        GAS float* rc = (GAS float*)WSP(float, WS_ROPEC); GAS float* rs = (GAS float*)WSP(float, WS_ROPES);
        for (int i = gt; i < 32768; i += NT) { const int t = i >> 5, p = i & 31; const float pos = (float)(p < 16 ? (t >> 6) : (t & 63)); const float inv = powf(10000.0f, -(float)(p & 15) * (1.0f / 16.0f));
            const float ang = pos * inv; rc[i] = cosf(ang); rs[i] = sinf(ang); }
        const f32x4* cak = (const f32x4*)INP(2); const f32x4* cbk = (const f32x4*)INP(4);
        GAS u32x2* CKa = (GAS u32x2*)WSP(u32x2, WS_CKA); GAS u32x2* CKb = (GAS u32x2*)WSP(u32x2, WS_CKB);
        for (int i = gt; i < 65536; i += NT) CKa[i] = pk4(cak[i]);
        for (int i = gt; i < 262144; i += NT) CKb[i] = pk4(cbk[i]);
    }
    if (wave == 0) {
        for (int sp = 0; sp < 400000; ++sp) { if ((unsigned)__builtin_amdgcn_readfirstlane(__hip_atomic_load((GAS unsigned*)(F.ws + WS_CTL) + CW_MODCNT, __ATOMIC_RELAXED, __HIP_MEMORY_SCOPE_AGENT)) >= 192u) break; __builtin_amdgcn_s_sleep(2); }
        __builtin_amdgcn_fence(__ATOMIC_ACQUIRE, "agent");
    }
    asm volatile("s_waitcnt vmcnt(0) lgkmcnt(0)" ::: "memory"); __syncthreads();
}

__device__ __forceinline__ void row_phase(Frame& F, ArgsP args, int l, int which) {
    asm volatile("" : "+s"(args));
    const int tid = opaque_tid(), lane = tid & 63, wave = __builtin_amdgcn_readfirstlane(tid >> 6);
    const int gw = F.vcu * NWAVES + wave, NGW = F.G * NWAVES;
    const float* mod = WSP(float, WS_MOD); const bf16_t* Y = WSP(bf16_t, WS_Y); bf16_t* H = WSP(bf16_t, WS_H); float* const outp = (float*)F.out;
    int lh = l, wh = 0;
    if (which == 1) wh = 1; else if (which == 2) { lh = l + 1; wh = 0; }
    const bool has_h = lh < DEPTH; const int lhc = has_h ? lh : 0;
    f32x4 gpo[4], gpr[4];
    { const float* gp = INP(11) + (size_t)(l * 2 + (which == 0 ? 0 : which - 1)) * DM; const float* gq = INP(10) + (size_t)(lhc * 2 + wh) * DM;
#pragma unroll
      for (int j = 0; j < 4; ++j) { gpo[j] = *(const f32x4*)(gp + 256 * j + 4 * lane); gpr[j] = *(const f32x4*)(gq + 256 * j + 4 * lane); } }
    for (int m0 = gw; m0 < NTOK; m0 += 2 * NGW) {
        f32x4 x[2][4], gt[2][4], sh[2][4], sc[2][4]; u32x2 yb[2][4];
#pragma unroll
        for (int r = 0; r < 2; ++r) { const int m = m0 + r * NGW; const int ci = m < NCTX ? 0 : 1 + ((m - NCTX) >> 10);
            const float* xsrc = (which == 0 || (which == 1 && l == 0)) ? (m < NCTX ? INP(0) + (size_t)m * DM : INP(1) + (size_t)(m - NCTX) * DM) : outp + (size_t)m * DM;
            const float* gate = mod + (size_t)(l * 5 + ci) * 6144 + (which == 1 ? 2048 : 5120); const float* mm = mod + (size_t)(lhc * 5 + ci) * 6144 + (wh ? 3072 : 0);
#pragma unroll
            for (int j = 0; j < 4; ++j) { x[r][j] = *(const f32x4*)(xsrc + 256 * j + 4 * lane);
                if (which != 0) { yb[r][j] = *(const u32x2*)(Y + (size_t)m * DM + 256 * j + 4 * lane); gt[r][j] = *(const f32x4*)(gate + 256 * j + 4 * lane); }
                if (has_h) { sh[r][j] = *(const f32x4*)(mm + 256 * j + 4 * lane); sc[r][j] = *(const f32x4*)(mm + 1024 + 256 * j + 4 * lane); } } }
#pragma unroll
        for (int r = 0; r < 2; ++r) { const int m = m0 + r * NGW;
            if (which != 0) {
                f32x4 y[4]; float s = 0.f;
#pragma unroll
                for (int j = 0; j < 4; ++j) { const u32x2 w = yb[r][j]; y[j][0] = __builtin_bit_cast(float, w.x << 16); y[j][1] = __builtin_bit_cast(float, w.x & 0xffff0000u); y[j][2] = __builtin_bit_cast(float, w.y << 16); y[j][3] = __builtin_bit_cast(float, w.y & 0xffff0000u);
                    s += (y[j][0] * y[j][0] + y[j][1] * y[j][1]) + (y[j][2] * y[j][2] + y[j][3] * y[j][3]); }
                const float rstd = 1.0f / sqrtf(wave_sum(s, lane) * (1.0f / DM) + NORM_EPS);
#pragma unroll
                for (int j = 0; j < 4; ++j) { x[r][j] = x[r][j] + gt[r][j] * (y[j] * rstd * gpo[j]); st16f(outp + (size_t)m * DM + 256 * j + 4 * lane, x[r][j]); }
            }
            if (has_h) {
                float s = 0.f;
#pragma unroll
                for (int j = 0; j < 4; ++j) s += (x[r][j][0] * x[r][j][0] + x[r][j][1] * x[r][j][1]) + (x[r][j][2] * x[r][j][2] + x[r][j][3] * x[r][j][3]);
                const float rstd = 1.0f / sqrtf(wave_sum(s, lane) * (1.0f / DM) + NORM_EPS);
#pragma unroll
                for (int j = 0; j < 4; ++j) { const f32x4 h = (x[r][j] * rstd * gpr[j]) * (1.0f + sc[r][j]) + sh[r][j]; st8(H + (size_t)m * DM + 256 * j + 4 * lane, pk4(h)); }
            }
        }
    }
}

#define MFMA32(a, b, c) __builtin_amdgcn_mfma_f32_32x32x16_bf16((a), (b), (c), 0, 0, 0)
constexpr int ATT_KPITCH = 144;
constexpr int ATT_VT_OFF = 69120;
__device__ __forceinline__ int crow0(int r) { return (r & 3) + 8 * (r >> 2); }
template <int SEGLEN, int NU>
__device__ __forceinline__ void stage_k_issue(u32x4 (&v)[NU], const bf16_t* src, int nrows, int segstride, int ldk, int tid) {
#pragma unroll
    for (int u = 0; u < NU; ++u) { const int x = tid + NWAVES * 64 * u, r0 = x >> 3, r = r0 < nrows ? r0 : nrows - 1, c = x & 7, sg = r / SEGLEN, j = r - sg * SEGLEN;
        v[u] = *(const u32x4*)(src + (size_t)(sg * segstride + j) * ldk + c * 8); }
}
template <int NU>
__device__ __forceinline__ void stage_k_commit(const u32x4 (&v)[NU], LAS unsigned char* dst, int nrows, int tid) {
#pragma unroll
    for (int u = 0; u < NU; ++u) { const int x = tid + NWAVES * 64 * u, r = x >> 3, c = x & 7;
        if (r < nrows) *(LAS u32x4*)(dst + r * ATT_KPITCH + c * 16) = v[u]; }
}
template <int SEGLEN, int NU>
__device__ __forceinline__ void stage_vt_issue(u32x2 (&v)[2][NU], const bf16_t* src, int NK, int segstride, int T, int tid) {
    const int d0 = tid >> 4, sub = tid & 15;
#pragma unroll
    for (int ps = 0; ps < 2; ++ps)
#pragma unroll
        for (int u = 0; u < NU; ++u) { const int k0 = 4 * (sub + 16 * u), k = k0 < NK ? k0 : NK - 4, sg = k / SEGLEN, j = k - sg * SEGLEN;
            v[ps][u] = *(const u32x2*)(src + (size_t)(d0 + 32 * ps) * T + sg * segstride + j); }
}
template <int NU>
__device__ __forceinline__ void stage_vt_commit(const u32x2 (&v)[2][NU], LAS unsigned char* dst, int NK, int pitchB, int tid) {
    const int d0 = tid >> 4, sub = tid & 15;
#pragma unroll
    for (int ps = 0; ps < 2; ++ps)
#pragma unroll
        for (int u = 0; u < NU; ++u) { const int k = 4 * (sub + 16 * u);
            if (k < NK) *(LAS u32x2*)(dst + (d0 + 32 * ps) * pitchB + k * 2) = v[ps][u]; }
}
template <int MASK>
__device__ __forceinline__ void att_tile(const LAS unsigned char* kp, const LAS unsigned char* vp0, const LAS unsigned char* vp1, const bf16x8 (&qf)[4], f32x16& o0, f32x16& o1, float& m, float& l, int mi0, bool rowok, const LAS float* tb, int lane) {
    bf16x8 kf[4];
#pragma unroll
    for (int st = 0; st < 4; ++st) kf[st] = *(const LAS bf16x8*)(kp + 32 * st);
    s16x4 v0l[2], v0h[2], v1l[2], v1h[2];
#pragma unroll
    for (int s = 0; s < 2; ++s) { v0l[s] = *(const LAS s16x4*)(vp0 + 32 * s); v0h[s] = *(const LAS s16x4*)(vp0 + 32 * s + 16); v1l[s] = *(const LAS s16x4*)(vp1 + 32 * s); v1h[s] = *(const LAS s16x4*)(vp1 + 32 * s + 16); }
    f32x16 sc;
#pragma unroll
    for (int r = 0; r < 16; ++r) sc[r] = 0.f;
#pragma unroll
    for (int st = 0; st < 4; ++st) sc = MFMA32(kf[st], qf[st], sc);
    if (MASK == 2) {
#pragma unroll
        for (int r = 0; r < 16; ++r) { const int d = mi0 + crow0(r); if ((unsigned)(d + 128) > 256u) sc[r] = NEGBIG; }
    }
    if (MASK == 3) {
#pragma unroll
        for (int r = 0; r < 16; ++r) { const bool ok = rowok && ((unsigned)(crow0(r) - mi0) < 16u); sc[r] = ok ? sc[r] + tb[crow0(r)] : NEGBIG; }
    }
    float mx = sc[0];
#pragma unroll
    for (int r = 1; r < 16; ++r) mx = fmax_nc(mx, sc[r]);
    mx = fmax_nc(mx, shx(mx, 32, lane));
    const float mn = fmax_nc(m, mx), alpha = __builtin_amdgcn_exp2f(m - mn); m = mn;
    float ps = 0.f;
#pragma unroll
    for (int r = 0; r < 16; ++r) { sc[r] = __builtin_amdgcn_exp2f(sc[r] - mn); ps += sc[r]; }
    l = l * alpha + ps;
#pragma unroll
    for (int r = 0; r < 16; ++r) { o0[r] *= alpha; o1[r] *= alpha; }
    u32x4 p0, p1;
    p0.x = pk2(sc[0], sc[1]); p0.y = pk2(sc[2], sc[3]); p0.z = pk2(sc[4], sc[5]); p0.w = pk2(sc[6], sc[7]);
    p1.x = pk2(sc[8], sc[9]); p1.y = pk2(sc[10], sc[11]); p1.z = pk2(sc[12], sc[13]); p1.w = pk2(sc[14], sc[15]);
    const bf16x8 pb0 = __builtin_bit_cast(bf16x8, p0), pb1 = __builtin_bit_cast(bf16x8, p1);
#define VF(lo, hi) (bf16x8){lo[0], lo[1], lo[2], lo[3], hi[0], hi[1], hi[2], hi[3]}
    o0 = MFMA32(VF(v0l[0], v0h[0]), pb0, o0); o0 = MFMA32(VF(v0l[1], v0h[1]), pb1, o0);
    o1 = MFMA32(VF(v1l[0], v1h[0]), pb0, o1); o1 = MFMA32(VF(v1l[1], v1h[1]), pb1, o1);
#undef VF
}
__device__ __forceinline__ float half_max(float v) { unsigned w = __builtin_bit_cast(unsigned, v); asm volatile("" : "+v"(w));
    const auto rr = __builtin_amdgcn_permlane32_swap(__builtin_bit_cast(unsigned, v), w, false, false);
    unsigned x0 = rr[0], x1 = rr[1]; asm volatile("" : "+v"(x0), "+v"(x1));
    return fmax_nc(__builtin_bit_cast(float, x0), __builtin_bit_cast(float, x1)); }
template <int MASK, bool LATEV = false>
__device__ __forceinline__ void att_tile2(const LAS unsigned char* kpA, const LAS unsigned char* vA0, const LAS unsigned char* vA1, int miA, bool okA, const LAS float* tbA,
                                          const LAS unsigned char* kpB, const LAS unsigned char* vB0, const LAS unsigned char* vB1, int miB, bool okB, const LAS float* tbB,
                                          const bf16x8 (&qf)[4], f32x16& o0, f32x16& o1, float& m, float& l) {
    f32x16 sa, sb;
#pragma unroll
    for (int r = 0; r < 16; ++r) { sa[r] = 0.f; sb[r] = 0.f; }
    {
        bf16x8 ka[4], kb[4];
#pragma unroll
        for (int st = 0; st < 4; ++st) { ka[st] = *(const LAS bf16x8*)(kpA + 32 * st); kb[st] = *(const LAS bf16x8*)(kpB + 32 * st); }
#pragma unroll
        for (int st = 0; st < 4; ++st) { sa = MFMA32(ka[st], qf[st], sa); sb = MFMA32(kb[st], qf[st], sb); }
    }
    s16x4 a0l[2], a0h[2], a1l[2], a1h[2], b0l[2], b0h[2], b1l[2], b1h[2];
    if (!LATEV) {
#pragma unroll
    for (int s = 0; s < 2; ++s) { a0l[s] = *(const LAS s16x4*)(vA0 + 32 * s); a0h[s] = *(const LAS s16x4*)(vA0 + 32 * s + 16); a1l[s] = *(const LAS s16x4*)(vA1 + 32 * s); a1h[s] = *(const LAS s16x4*)(vA1 + 32 * s + 16);
                                  b0l[s] = *(const LAS s16x4*)(vB0 + 32 * s); b0h[s] = *(const LAS s16x4*)(vB0 + 32 * s + 16); b1l[s] = *(const LAS s16x4*)(vB1 + 32 * s); b1h[s] = *(const LAS s16x4*)(vB1 + 32 * s + 16); }
    }
    if (MASK == 2) {
#pragma unroll
        for (int r = 0; r < 16; ++r) { const int da = miA + crow0(r), db = miB + crow0(r); if ((unsigned)(da + 128) > 256u) sa[r] = NEGBIG; if ((unsigned)(db + 128) > 256u) sb[r] = NEGBIG; }
    }
    if (MASK == 3) {
#pragma unroll
        for (int r = 0; r < 16; ++r) { const bool wa = okA && ((unsigned)(crow0(r) - miA) < 16u), wb = okB && ((unsigned)(crow0(r) - miB) < 16u);
            sa[r] = wa ? sa[r] + tbA[crow0(r)] : NEGBIG; sb[r] = wb ? sb[r] + tbB[crow0(r)] : NEGBIG; }
    }
    float mx = fmax_nc(sa[0], sb[0]);
#pragma unroll
    for (int r = 1; r < 16; ++r) mx = fmax_nc(mx, fmax_nc(sa[r], sb[r]));
    mx = half_max(mx);
    if (__builtin_amdgcn_ballot_w64(mx > m) != 0ull) {
        const float mn = fmax_nc(m, mx), alpha = __builtin_amdgcn_exp2f(m - mn); m = mn; l *= alpha;
#pragma unroll
        for (int r = 0; r < 16; ++r) { o0[r] *= alpha; o1[r] *= alpha; }
    }
    f32x2v ps2 = {0.f, 0.f}; const f32x2v m2 = {m, m};
#pragma unroll
    for (int r = 0; r < 16; r += 2) { f32x2v ta = {sa[r], sa[r + 1]}, tb2 = {sb[r], sb[r + 1]}; ta = ta - m2; tb2 = tb2 - m2;
        sa[r] = __builtin_amdgcn_exp2f(ta.x); sa[r + 1] = __builtin_amdgcn_exp2f(ta.y); sb[r] = __builtin_amdgcn_exp2f(tb2.x); sb[r + 1] = __builtin_amdgcn_exp2f(tb2.y);
        ps2 += (f32x2v){sa[r], sa[r + 1]} + (f32x2v){sb[r], sb[r + 1]}; }
    l += ps2.x + ps2.y;
    if (LATEV) { asm volatile("" ::: "memory");
#pragma unroll
    for (int s = 0; s < 2; ++s) { a0l[s] = *(const LAS s16x4*)(vA0 + 32 * s); a0h[s] = *(const LAS s16x4*)(vA0 + 32 * s + 16); a1l[s] = *(const LAS s16x4*)(vA1 + 32 * s); a1h[s] = *(const LAS s16x4*)(vA1 + 32 * s + 16);
                                  b0l[s] = *(const LAS s16x4*)(vB0 + 32 * s); b0h[s] = *(const LAS s16x4*)(vB0 + 32 * s + 16); b1l[s] = *(const LAS s16x4*)(vB1 + 32 * s); b1h[s] = *(const LAS s16x4*)(vB1 + 32 * s + 16); }
    }
    u32x4 pa0, pa1, pb0, pb1;
    pa0.x = pk2(sa[0], sa[1]); pa0.y = pk2(sa[2], sa[3]); pa0.z = pk2(sa[4], sa[5]); pa0.w = pk2(sa[6], sa[7]);
    pa1.x = pk2(sa[8], sa[9]); pa1.y = pk2(sa[10], sa[11]); pa1.z = pk2(sa[12], sa[13]); pa1.w = pk2(sa[14], sa[15]);
    pb0.x = pk2(sb[0], sb[1]); pb0.y = pk2(sb[2], sb[3]); pb0.z = pk2(sb[4], sb[5]); pb0.w = pk2(sb[6], sb[7]);
    pb1.x = pk2(sb[8], sb[9]); pb1.y = pk2(sb[10], sb[11]); pb1.z = pk2(sb[12], sb[13]); pb1.w = pk2(sb[14], sb[15]);
    const bf16x8 qa0 = __builtin_bit_cast(bf16x8, pa0), qa1 = __builtin_bit_cast(bf16x8, pa1), qb0 = __builtin_bit_cast(bf16x8, pb0), qb1 = __builtin_bit_cast(bf16x8, pb1);
#define VF(lo, hi) (bf16x8){lo[0], lo[1], lo[2], lo[3], hi[0], hi[1], hi[2], hi[3]}
    o0 = MFMA32(VF(a0l[0], a0h[0]), qa0, o0); o1 = MFMA32(VF(a1l[0], a1h[0]), qa0, o1);
    o0 = MFMA32(VF(a0l[1], a0h[1]), qa1, o0); o1 = MFMA32(VF(a1l[1], a1h[1]), qa1, o1);
    o0 = MFMA32(VF(b0l[0], b0h[0]), qb0, o0); o1 = MFMA32(VF(b1l[0], b1h[0]), qb0, o1);
    o0 = MFMA32(VF(b0l[1], b0h[1]), qb1, o0); o1 = MFMA32(VF(b1l[1], b1h[1]), qb1, o1);
#undef VF
}
__device__ __forceinline__ int r0_of(int r) { const int v = r - 4; return v < 0 ? 0 : (v > 8 ? 8 : v); }
template <int MODE>
__device__ __forceinline__ void attn_unit(Frame& F, ArgsP args, int layer, int unit, int pm = 0) {
    asm volatile("" : "+s"(args));
    const int tid = opaque_tid(), lane = tid & 63, wave = __builtin_amdgcn_readfirstlane(tid >> 6), q = lane & 31, hh = lane >> 5;
    const bf16_t* Qa = WSP(bf16_t, WS_QA); const bf16_t* Ka = WSP(bf16_t, WS_KA); const bf16_t* VaT = WSP(bf16_t, WS_VAT);
    const bf16_t* Qb = WSP(bf16_t, WS_QB); const bf16_t* Kb = WSP(bf16_t, WS_KB); const bf16_t* VbT = WSP(bf16_t, WS_VBT);
    bf16_t* OC = WSP(bf16_t, WS_OC);
    LAS unsigned char* Ks = F.lds; LAS unsigned char* VTs = F.lds + ATT_VT_OFF;
    LAS float* tab = (LAS float*)(F.lds + TW_OFF);
    constexpr bool isA = (MODE == 0 || MODE == 2);
    int b, head, tokq, kvh;
    int blk = 0, tq0 = 0, seg_lo = 0, NK = 256, rh = 0, ch = 0, qr = 0, qc = 0, qr0w = 0, nblk = 0, klo = 0, nrows = 0, cs_lo = 0;
    if (MODE < 2) { b = unit >> 3; head = unit & 7; tokq = b * 256 + 32 * wave + q; }
    else if (MODE == 2) { b = unit >> 5; const int hp = (unit >> 3) & 3; blk = unit & 7; head = 2 * hp + (wave >> 2); tq0 = 128 * blk + 32 * (wave & 3); tokq = NCTX + b * 1024 + tq0 + q;
        seg_lo = blk == 0 ? 0 : 128 * blk - 128; const int seg_hi = blk == 7 ? 1024 : 128 * blk + 256; NK = seg_hi - seg_lo; }
    else { b = unit >> 5; head = (unit >> 2) & 7; rh = (unit >> 1) & 1; ch = unit & 1; qr0w = 8 * rh + 2 * (wave >> 1); nblk = 2 * ch + (wave & 1); qr = qr0w + (q >> 4); qc = 16 * nblk + (q & 15);
        tokq = NCTX + b * 1024 + qr * 64 + qc; klo = rh ? 4 : 0; nrows = rh ? 12 : 11; cs_lo = ch ? 24 : 0; NK = nrows * 40; }
    kvh = isA ? (head >> 2) : head;
    const int pitchB = (NK + 4) * 2;
    __syncthreads();
    constexpr int NU1 = MODE < 2 ? 4 : (MODE == 2 ? 6 : 8);
    u32x4 rk[NU1]; u32x2 rv[2][NU1]; bf16x8 qf[4]; float rt0 = 0.f, rt1 = 0.f, rsink = 0.f;
    if (MODE == 0) { stage_k_issue<256, NU1>(rk, Ka + (size_t)(b * 256) * 128 + kvh * 64, 256, 0, 128, tid); stage_vt_issue<256, NU1>(rv, VaT + (size_t)((b * 2 + kvh) * 64) * 256, 256, 0, 256, tid); }
    else if (MODE == 1) { stage_k_issue<256, NU1>(rk, Kb + (size_t)(b * 256) * 512 + head * 64, 256, 0, 512, tid); stage_vt_issue<256, NU1>(rv, VbT + (size_t)((b * 8 + head) * 64) * 256, 256, 0, 256, tid); }
    else if (MODE == 2) { stage_k_issue<128, NU1>(rk, Ka + (size_t)(NCTX + b * 1024 + seg_lo) * 128 + kvh * 64, NK, 128, 128, tid);
        stage_vt_issue<128, NU1>(rv, VaT + 524288 + (size_t)((b * 2 + kvh) * 64) * 1024 + seg_lo, NK, 128, 1024, tid); }
    else { stage_k_issue<40, NU1>(rk, Kb + (size_t)(NCTX + b * 1024 + klo * 64 + cs_lo) * 512 + head * 64, NK, 64, 512, tid);
        stage_vt_issue<40, NU1>(rv, VbT + 2097152 + (size_t)((b * 8 + head) * 64) * 1024 + klo * 64 + cs_lo, NK, 64, 1024, tid);
        const float* rp = INP(14) + (size_t)(layer * 8 + head) * 465;
        { const int j0 = tid - 47, j1 = tid + 512 - 47; rt0 = rp[j0 < 0 ? 0 : (j0 > 464 ? 464 : j0)]; rt1 = rp[j1 > 464 ? 464 : j1]; } }
    { const bf16_t* qp = (isA ? Qa : Qb) + (size_t)tokq * 512 + head * 64 + 8 * hh;
#pragma unroll
      for (int st = 0; st < 4; ++st) qf[st] = *(const bf16x8*)(qp + 16 * st); }
    if (isA) rsink = INP(13)[layer * 8 + head];
    if (!(pm & 128)) {
        stage_k_commit<NU1>(rk, Ks, NK, tid); stage_vt_commit<NU1>(rv, VTs, NK, pitchB, tid);
        if (MODE == 3) { const int j0 = tid - 47, j1 = tid + 512 - 47; tab[tid] = (j0 >= 0 && j0 < 465) ? rt0 * LOG2E : 0.f; if (tid + 512 < 640) tab[tid + 512] = (j1 < 465) ? rt1 * LOG2E : 0.f; }
    }
    f32x16 o0, o1;
#pragma unroll
    for (int r = 0; r < 16; ++r) { o0[r] = 0.f; o1[r] = 0.f; }
    float m = MINIT, l = 0.f;
    if (isA) { m = rsink * LOG2E; l = hh == 0 ? 1.f : 0.f; }
    __syncthreads();
    u32x4 ck[4]; u32x2 cv[2][4];
    if (MODE >= 2) { const int bl = b * 2 + layer;
        if (MODE == 2) { stage_k_issue<256, 4>(ck, WSP(bf16_t, WS_CKA) + (size_t)bl * 256 * 128 + kvh * 64, 256, 0, 128, tid); stage_vt_issue<256, 4>(cv, WSP(bf16_t, WS_CVAT) + (size_t)((bl * 2 + kvh) * 64) * 256, 256, 0, 256, tid); }
        else { stage_k_issue<256, 4>(ck, WSP(bf16_t, WS_CKB) + (size_t)bl * 256 * 512 + head * 64, 256, 0, 512, tid); stage_vt_issue<256, 4>(cv, WSP(bf16_t, WS_CVBT) + (size_t)((bl * 8 + head) * 64) * 256, 256, 0, 256, tid); } }
    const LAS unsigned char* kq = Ks + q * ATT_KPITCH + 16 * hh;
    const LAS unsigned char* vq0 = VTs + q * pitchB + 8 * hh;
    const LAS unsigned char* vq1 = vq0 + 32 * pitchB;
    if (pm & 64) {} else
    if (MODE < 2) {
        for (int i = 0; i < 8; i += 2) att_tile2<0>(kq + 32 * i * ATT_KPITCH, vq0 + 64 * i, vq1 + 64 * i, 0, true, tab, kq + 32 * (i + 1) * ATT_KPITCH, vq0 + 64 * (i + 1), vq1 + 64 * (i + 1), 0, true, tab, qf, o0, o1, m, l);
    } else if (MODE == 2) {
        const int slo = tq0 - 128 < 0 ? 0 : tq0 - 128, shi = tq0 + 128 > 992 ? 992 : tq0 + 128;
        int s0 = slo;
        for (; s0 + 32 <= shi; s0 += 64) { const int koff = s0 - seg_lo, mi = s0 - tq0 - q + 4 * hh;
            att_tile2<2>(kq + koff * ATT_KPITCH, vq0 + koff * 2, vq1 + koff * 2, mi, true, tab, kq + (koff + 32) * ATT_KPITCH, vq0 + (koff + 32) * 2, vq1 + (koff + 32) * 2, mi + 32, true, tab, qf, o0, o1, m, l); }
        if (s0 <= shi) { const int koff = s0 - seg_lo;
            att_tile<2>(kq + koff * ATT_KPITCH, vq0 + koff * 2, vq1 + koff * 2, qf, o0, o1, m, l, s0 - tq0 - q + 4 * hh, true, tab, lane); }
    } else {
        const int rlo = r0_of(qr0w), rhi = r0_of(qr0w + 1) + 7; const int cs = nblk == 0 ? 0 : (nblk == 1 ? 8 : (nblk == 2 ? 24 : 32));
        const int r0q = r0_of(qr); int wsq = qc - 8; wsq = wsq < 0 ? 0 : (wsq > 48 ? 48 : wsq);
        const int lo = wsq - cs - 4 * hh;
        int kr = rlo;
        for (; kr + 1 <= rhi; kr += 2) {
            const int koff = (kr - klo) * 40 + (cs - cs_lo); const bool okA = (unsigned)(kr - r0q) < 8u, okB = (unsigned)(kr + 1 - r0q) < 8u;
            const LAS float* tb = tab + (kr - qr + 8) * 31 + (cs + 4 * hh - qc + 15) + 16;
            att_tile2<3>(kq + koff * ATT_KPITCH, vq0 + koff * 2, vq1 + koff * 2, lo, okA, tb, kq + (koff + 40) * ATT_KPITCH, vq0 + (koff + 40) * 2, vq1 + (koff + 40) * 2, lo, okB, tb + 31, qf, o0, o1, m, l);
        }
        if (kr <= rhi) {
            const int koff = (kr - klo) * 40 + (cs - cs_lo); const bool rowok = (unsigned)(kr - r0q) < 8u;
            const LAS float* tb = tab + (kr - qr + 8) * 31 + (cs + 4 * hh - qc + 15) + 16;
            att_tile<3>(kq + koff * ATT_KPITCH, vq0 + koff * 2, vq1 + koff * 2, qf, o0, o1, m, l, lo, rowok, tb, lane);
        }
    }
    if (MODE >= 2 && !(pm & 256)) {
        __syncthreads();
        const int bl = b * 2 + layer; constexpr int pitchC = (256 + 4) * 2;
        if (!(pm & 128)) { stage_k_commit<4>(ck, Ks, 256, tid); stage_vt_commit<4>(cv, VTs, 256, pitchC, tid); }
        __syncthreads();
        const LAS unsigned char* cq0 = VTs + q * pitchC + 8 * hh; const LAS unsigned char* cq1 = cq0 + 32 * pitchC;
        if (!(pm & 64)) for (int i = 0; i < 8; i += 2) att_tile2<0>(kq + 32 * i * ATT_KPITCH, cq0 + 64 * i, cq1 + 64 * i, 0, true, tab, kq + 32 * (i + 1) * ATT_KPITCH, cq0 + 64 * (i + 1), cq1 + 64 * (i + 1), 0, true, tab, qf, o0, o1, m, l);
    }
    const float lt = l + shx(l, 32, lane), inv = 1.0f / lt;
    bf16_t* op = OC + (size_t)tokq * 2048 + (isA ? 0 : 512) + head * 64 + 8 * hh;
#pragma unroll
    for (int k = 0; k < 2; ++k) { u32x2 pa[2], pc[2];
#pragma unroll
        for (int e = 0; e < 2; ++e) { const int g = 2 * k + e;
            f32x4 a = {o0[4 * g] * inv, o0[4 * g + 1] * inv, o0[4 * g + 2] * inv, o0[4 * g + 3] * inv};
            f32x4 c = {o1[4 * g] * inv, o1[4 * g + 1] * inv, o1[4 * g + 2] * inv, o1[4 * g + 3] * inv};
            pa[e] = pk4(a); pc[e] = pk4(c); }
        st16u(op + 16 * k, pair32(pa[0], pa[1])); st16u(op + 32 + 16 * k, pair32(pc[0], pc[1]));
    }
}

__device__ __forceinline__ void attn_latA_pair(Frame& F, ArgsP args, int layer, int un2) {
    asm volatile("" : "+s"(args));
    const int tid = opaque_tid(), lane = tid & 63, wave = __builtin_amdgcn_readfirstlane(tid >> 6), q = lane & 31, hh = lane >> 5;
    const bf16_t* Qa = WSP(bf16_t, WS_QA); const bf16_t* Ka = WSP(bf16_t, WS_KA); const bf16_t* VaT = WSP(bf16_t, WS_VAT); bf16_t* OC = WSP(bf16_t, WS_OC);
    LAS unsigned char* Ks = F.lds; LAS unsigned char* VTs = F.lds + ATT_VT_OFF; const LAS float* tab = (const LAS float*)(F.lds + TW_OFF);
    const int b = un2 >> 4, kvh = (un2 >> 3) & 1, blk = un2 & 7, bl = b * 2 + layer;
    const int tq0 = 128 * blk + 32 * (wave & 3), tokq = NCTX + b * 1024 + tq0 + q;
    const int seg_lo = blk == 0 ? 0 : 128 * blk - 128, seg_hi = blk == 7 ? 1024 : 128 * blk + 256, NK = seg_hi - seg_lo, pitchB = (NK + 4) * 2;
    __syncthreads();
    u32x4 rk[6]; u32x2 rv[2][6]; bf16x8 qf[2][4]; float rsink[2];
    stage_k_issue<128, 6>(rk, Ka + (size_t)(NCTX + b * 1024 + seg_lo) * 128 + kvh * 64, NK, 128, 128, tid);
    stage_vt_issue<128, 6>(rv, VaT + 524288 + (size_t)((b * 2 + kvh) * 64) * 1024 + seg_lo, NK, 128, 1024, tid);
#pragma unroll
    for (int p = 0; p < 2; ++p) { const int head = 4 * kvh + 2 * p + (wave >> 2); const bf16_t* qp = Qa + (size_t)tokq * 512 + head * 64 + 8 * hh;
#pragma unroll
        for (int st = 0; st < 4; ++st) qf[p][st] = *(const bf16x8*)(qp + 16 * st);
        rsink[p] = INP(13)[layer * 8 + head]; }
    stage_k_commit<6>(rk, Ks, NK, tid); stage_vt_commit<6>(rv, VTs, NK, pitchB, tid);
    f32x16 o0[2], o1[2]; float m[2], l[2];
#pragma unroll
    for (int p = 0; p < 2; ++p) {
#pragma unroll
        for (int r = 0; r < 16; ++r) { o0[p][r] = 0.f; o1[p][r] = 0.f; }
        m[p] = rsink[p] * LOG2E; l[p] = hh == 0 ? 1.f : 0.f; }
    __syncthreads();
    const LAS unsigned char* kq = Ks + q * ATT_KPITCH + 16 * hh;
    {
        const LAS unsigned char* vq0 = VTs + q * pitchB + 8 * hh; const LAS unsigned char* vq1 = vq0 + 32 * pitchB;
        const int slo = tq0 - 128 < 0 ? 0 : tq0 - 128, shi = tq0 + 128 > 992 ? 992 : tq0 + 128;
        int s0 = slo;
        for (; s0 + 32 <= shi; s0 += 64) { const int koff = s0 - seg_lo, mi = s0 - tq0 - q + 4 * hh;
#pragma unroll
            for (int p = 0; p < 2; ++p)
                att_tile2<2, true>(kq + koff * ATT_KPITCH, vq0 + koff * 2, vq1 + koff * 2, mi, true, tab, kq + (koff + 32) * ATT_KPITCH, vq0 + (koff + 32) * 2, vq1 + (koff + 32) * 2, mi + 32, true, tab, qf[p], o0[p], o1[p], m[p], l[p]); }
        if (s0 <= shi) { const int koff = s0 - seg_lo;
#pragma unroll
            for (int p = 0; p < 2; ++p) att_tile<2>(kq + koff * ATT_KPITCH, vq0 + koff * 2, vq1 + koff * 2, qf[p], o0[p], o1[p], m[p], l[p], s0 - tq0 - q + 4 * hh, true, tab, lane); }
    }
    constexpr int pitchC = (256 + 4) * 2;
    { u32x4 ck[4]; u32x2 cv[2][4];
      stage_k_issue<256, 4>(ck, WSP(bf16_t, WS_CKA) + (size_t)bl * 256 * 128 + kvh * 64, 256, 0, 128, tid); stage_vt_issue<256, 4>(cv, WSP(bf16_t, WS_CVAT) + (size_t)((bl * 2 + kvh) * 64) * 256, 256, 0, 256, tid);
      __syncthreads();
      stage_k_commit<4>(ck, Ks, 256, tid); stage_vt_commit<4>(cv, VTs, 256, pitchC, tid); }
    __syncthreads();
    { const LAS unsigned char* cq0 = VTs + q * pitchC + 8 * hh; const LAS unsigned char* cq1 = cq0 + 32 * pitchC;
      for (int i = 0; i < 8; i += 2) {
#pragma unroll
          for (int p = 0; p < 2; ++p)
              att_tile2<0, true>(kq + 32 * i * ATT_KPITCH, cq0 + 64 * i, cq1 + 64 * i, 0, true, tab, kq + 32 * (i + 1) * ATT_KPITCH, cq0 + 64 * (i + 1), cq1 + 64 * (i + 1), 0, true, tab, qf[p], o0[p], o1[p], m[p], l[p]); } }
#pragma unroll
    for (int p = 0; p < 2; ++p) { const int head = 4 * kvh + 2 * p + (wave >> 2);
        const float lt = l[p] + shx(l[p], 32, lane), inv = 1.0f / lt;
        bf16_t* op = OC + (size_t)tokq * 2048 + head * 64 + 8 * hh;
#pragma unroll
        for (int k = 0; k < 2; ++k) { u32x2 pa[2], pc[2];
#pragma unroll
            for (int e = 0; e < 2; ++e) { const int g = 2 * k + e;
                f32x4 a = {o0[p][4 * g] * inv, o0[p][4 * g + 1] * inv, o0[p][4 * g + 2] * inv, o0[p][4 * g + 3] * inv};
                f32x4 c = {o1[p][4 * g] * inv, o1[p][4 * g + 1] * inv, o1[p][4 * g + 2] * inv, o1[p][4 * g + 3] * inv};
                pa[e] = pk4(a); pc[e] = pk4(c); }
            st16u(op + 16 * k, pair32(pa[0], pa[1])); st16u(op + 32 + 16 * k, pair32(pc[0], pc[1])); } }
}

struct BranchSched { unsigned A, B; int c, lm;
    __device__ __forceinline__ bool next(int i, pg8::Unit& u) const {
        if (c >= 256 || i >= 4) return false;
        if (lm) (void)pg8::tile_local(0, c, 8, 4, u.pm, u.pn); else pg8::tile_of(c, 64, 4, u.pm, u.pn);
        u.tag = i;
        u.A = A + (unsigned)u.pm * 128u * 2048u * 2u + (unsigned)i * 512u * 2u; u.B = B + (unsigned)i * DM * 512u * 2u + (unsigned)u.pn * 256u * 512u * 2u; return true; } };
struct FourLatSched { unsigned dft, UT; int c, lm;
    __device__ __forceinline__ bool next(int i, pg8::Unit& u) const {
        const int g = c >> 5, j = c & 31; if (j >= 8 || i >= 1) return false;
        const int b = g >> 1, nt = j & 1; int isq = g & 1, mt = j >> 1;
        if (lm) { isq = j >> 2; mt = 2 * (g & 1) + ((j >> 1) & 1); }
        u.pm = (NCTX + b * 1024 + mt * 256) >> 8; u.pn = (1024 + 512 * isq + 256 * nt) >> 8; u.tag = 0;
        u.A = dft + (unsigned)isq * 1024u * 1024u * 2u + (unsigned)mt * 256u * 1024u * 2u; u.B = UT + (2097152u + (unsigned)(b * 512 + nt * 256) * 1024u) * 2u; return true; } };
struct FourCtxSched { unsigned dft, UT; int c;
    __device__ __forceinline__ bool next(int i, pg8::Unit& u) const {
        const int g = c >> 5, j = c & 31; if (j < 8 || j >= 16 || i >= 1) return false;
        const int cc = g * 8 + (j - 8), b = cc >> 2, isq = (cc >> 1) & 1, nt = cc & 1;
        u.pm = b; u.pn = (1024 + 512 * isq + 256 * nt) >> 8; u.tag = 0;
        u.A = dft + (unsigned)isq * 256u * 256u * 2u; u.B = UT + (unsigned)(b * 512 + nt * 256) * 256u * 2u; return true; } };

constexpr int N_PHASES = 2 + 8 * DEPTH;
__global__ void __launch_bounds__(NWAVES * 64, 2) hybrid_fwd(Args args) {
    extern __shared__ __attribute__((aligned(16))) unsigned char lds_raw[];
    Frame F0;
    F0.lds = (LAS unsigned char*)lds_raw;
    F0.lm = 0; F0.G = gridDim.x; { const int bx = blockIdx.x; F0.vcu = (F0.G % 8 == 0) ? (bx % 8) * (F0.G / 8) + bx / 8 : bx; }
    ArgsP ap0 = (ArgsP)__builtin_amdgcn_kernarg_segment_ptr();
    asm volatile("" : "+s"(ap0));
    F0.out = (GAS float*)ap0->out; F0.ws = (GAS unsigned char*)ap0->ws;
    const int tid = threadIdx.x;
    volatile LAS unsigned* MISC = (volatile LAS unsigned*)(F0.lds + MISC_OFF);
    for (int u = tid; u < 256; u += NWAVES * 64) ((LAS unsigned*)(F0.lds + LDSCTL_OFF))[u] = 0u;
    __syncthreads();
    XcdBarrier bar; bar.bar = (unsigned*)(F0.ws + WS_CTL) + CW_BAR; bar.x = 0; bar.st = nullptr;
    if (!MK_PER_PHASE) bar = xcd_barrier_post((unsigned*)(F0.ws + WS_CTL) + CW_BAR, MISC + 8);
    const int lo = ap0->ph_lo, hi = ap0->ph_hi;
    const int bx0 = (int)blockIdx.x;
    for (int pass = 0; pass <= PROBE_TWICE; ++pass) {
    if (pass > 0) xcd_barrier(bar);
    int rep = 0;
    for (int ph = lo; ph < hi; ++ph) {
      {
        Frame F = F0; ArgsP ap = ap0; int bx = bx0;
        asm volatile("" : "+s"(F.ws), "+s"(F.out), "+s"(F.vcu), "+s"(F.G), "+s"(F.lm), "+s"(ap), "+s"(bx));
        const int cu = F.lm ? F.vcu : bx;
        if (ph == 0) { if (!(DIS & 1)) { p0_prologue(F, ap); row_phase(F, ap, 0, 0); } }
        else if (ph == 1) { continue; }
        else {
            const int l = (ph - 2) >> 3, k = (ph - 2) & 7; const int prep = (ph >= PROBE_PH && ph <= PROBE_HI && rep + 1 < PROBE_REP) ? 1 : 0; (void)prep;
            const unsigned wlo = (unsigned)WS_W + (unsigned)l * (unsigned)W_LAYER;
            if (k == 0) {
                pg8::GridSched S{(unsigned)WS_H, wlo + (unsigned)W_IN, 32, DIN / 256, F.G, cu, 256u * DM * 2u, 256u * DM * 2u, F.lm};
                pg8::EpiIn E{F.ws, F.out, l};
#if PROBE_EPI
                if (prep > 0) { pg8::EpiBf16Probe E2{WSP(bf16_t, WS_OC), 2048}; pg8::gemm_phase(F.lds, (const unsigned char*)F.ws, pg8::Dims{DM, DM, DM}, S, E2); } else
#endif
                if (!(DIS & 4)) pg8::gemm_phase(F.lds, (const unsigned char*)F.ws, pg8::Dims{DM, DM, DM}, S, E);
                if (l == 0) { pg8::Unit u3;
                    if (!S.next(2, u3)) { const int rk = F.lm ? (cu >> 5) * 4 + ((cu & 31) - 28) : cu - 224; const int t5 = opaque_tid();
                        if (rk >= 0 && rk < 32) p0_weight_items(F, ap, P0W_NIT + P0W_KEEP, P0W_NIT + P0W_KEEP + P0W_DEFER_A, rk * NWAVES + __builtin_amdgcn_readfirstlane(t5 >> 6), 32 * NWAVES, t5 & 63, true); } }
            } else if (k == 1) {
                pg8::EpiBf16 E{WSP(bf16_t, WS_OC), 2048};
                if (prep == 0 || !(PROBE_SKIP & 1)) { FourLatSched S{(unsigned)WS_DFTL, (unsigned)WS_UT, F.vcu, F.lm}; if (!(DIS & 8)) pg8::gemm_phase(F.lds, (const unsigned char*)F.ws, pg8::Dims{1024, 1024, 1024}, S, E); }
                if (prep == 0 || !(PROBE_SKIP & 1)) { FourCtxSched S{(unsigned)WS_DFTC, (unsigned)WS_UT, F.vcu}; if (!(DIS & 8)) pg8::gemm_phase(F.lds, (const unsigned char*)F.ws, pg8::Dims{256, 256, 256}, S, E); }
                if (!(DIS & 16) && (prep == 0 || !(PROBE_SKIP & 2))) {
                    const int g = F.vcu >> 5, j = F.vcu & 31, pmk = prep ? PROBE_SKIP : 0, lmd = F.lm;
                    auto cid = [&](int k) { return lmd ? (k < 16 ? 16 * g + k : 128 + 16 * g + (k - 16)) : g * 32 + k; };
                    auto lbid = [&](int k) { return lmd ? ((g >> 1) * 32 + (k >> 1) * 4 + (g & 1) * 2 + (k & 1)) : g * 16 + k; };
                    auto laid = [&](int k) { return lmd ? ((g >> 1) * 16 + (k >> 2) * 8 + 4 * (g & 1) + (k & 3)) : g * 8 + k; };
                    auto ctx = [&](int id) { if (id < 128) attn_unit<0>(F, ap, l, id, pmk); else attn_unit<1>(F, ap, l, id - 128, pmk); };
                    if (j < 8) ctx(cid(j));
                    else if (j < 16) { attn_unit<3>(F, ap, l, lbid(j - 8), pmk); ctx(cid(j)); }
                    else if (j < 24) attn_latA_pair(F, ap, l, laid(j - 16));
                    else { attn_unit<3>(F, ap, l, lbid(8 + (j - 24)), pmk); ctx(cid(16 + 2 * (j - 24))); ctx(cid(17 + 2 * (j - 24))); }
                }
            } else if (k == 2) {
                BranchSched S{(unsigned)WS_OC, wlo + (unsigned)W_BR, cu, F.lm};
                pg8::EpiBranch E{WSP(unsigned char, WS_G), WSP(bf16_t, WS_MB)};
                if (!(DIS & 32)) pg8::gemm_phase_hm(F.lds, (const unsigned char*)F.ws, pg8::Dims{512, 2048, 512}, S, E);
            } else if (k == 3) {
                pg8::GridSched S{(unsigned)WS_MB, wlo + (unsigned)W_OUT, 64, 4, F.G, cu, 128u * DM * 2u, 256u * DM * 2u, F.lm};
#if FUSED_ROWS
                pg8::EpiRow E{F.ws, F.out, (const float*)(const GAS float*)ap->in[0], (const float*)(const GAS float*)ap->in[1], (const float*)(const GAS float*)ap->in[10], (const float*)(const GAS float*)ap->in[11], F.lds, l, 1};
#else
                pg8::EpiBf16 E{WSP(bf16_t, WS_Y), DM};
#endif
                if (!(DIS & 64)) pg8::gemm_phase_hm(F.lds, (const unsigned char*)F.ws, pg8::Dims{DM, DM, DM}, S, E);
            } else if (k == 4) { if (FUSED_ROWS) continue; if (!(DIS & 2)) row_phase(F, ap, l, 1); }
            else if (k == 5) {
                pg8::GridSched S{(unsigned)WS_H, wlo + (unsigned)W_F1, 32, DFF2 / 256, F.G, cu, 256u * DM * 2u, 256u * DM * 2u, F.lm};
                pg8::EpiSwiGLU E{WSP(bf16_t, WS_AB)};
                if (!(DIS & 128)) pg8::gemm_phase(F.lds, (const unsigned char*)F.ws, pg8::Dims{DM, DM, DM}, S, E);
                if (l == 0) { pg8::Unit u3;
                    if (!S.next(2, u3)) { const int rk = F.lm ? (cu >> 5) * 8 + ((cu & 31) - 24) : cu - 192; const int t5 = opaque_tid();
                        if (rk >= 0 && rk < 64) p0_weight_items(F, ap, P0W_NIT + P0W_KEEP + P0W_DEFER_A, 2 * P0W_NIT, rk * NWAVES + __builtin_amdgcn_readfirstlane(t5 >> 6), 64 * NWAVES, t5 & 63, true); } }
            } else if (k == 6) {
                pg8::GridSched S{(unsigned)WS_AB, wlo + (unsigned)W_F2, 64, 4, F.G, cu, 128u * DFF * 2u, 256u * DFF * 2u, F.lm};
#if FUSED_ROWS
                pg8::EpiRow E{F.ws, F.out, (const float*)(const GAS float*)ap->in[0], (const float*)(const GAS float*)ap->in[1], (const float*)(const GAS float*)ap->in[10], (const float*)(const GAS float*)ap->in[11], F.lds, l, 2};
#else
                pg8::EpiBf16 E{WSP(bf16_t, WS_Y), DM};
#endif
                if (!(DIS & 256)) pg8::gemm_phase_hm(F.lds, (const unsigned char*)F.ws, pg8::Dims{DFF, DFF, DFF}, S, E);
            } else { if (FUSED_ROWS) continue; if (!(DIS & 2)) row_phase(F, ap, l, 2); }
        }
      }
        if (ph == PROBE_HI && rep + 1 < PROBE_REP) { ++rep; ph = PROBE_PH - 1; xcd_barrier(bar); continue; }
        if (ph + 1 < hi) {
            const int kk = (ph - 2) & 7;
            if (F0.lm && ph >= 2 && (kk == 1 || kk == 2 || kk == 3 || kk == 5)) xcd_local_barrier(bar);
            else if (F0.lm && ph >= 2 && kk == 0) xcd_pair_barrier(bar);
            else xcd_barrier(bar);
            for (int eb = 0; eb < PROBE_BAR; ++eb) xcd_barrier(bar);
            if (ph == 0 && !MK_PER_PHASE) {
                const int lm = (int)__builtin_amdgcn_readfirstlane(MISC[10]);
                if (lm) { F0.lm = 1; F0.vcu = (int)__builtin_amdgcn_readfirstlane(MISC[12]) * 32 + (int)__builtin_amdgcn_readfirstlane(MISC[11]); }
            }
        }
    }
    }
}

extern "C" void kernel_launch(void* const* d_in, const int* in_sizes, int n_in, void* d_out, int out_size, void* d_ws, size_t ws_size, hipStream_t stream) {
    static int grid = 0;
    if (grid == 0) {
        if (n_in != 19 || out_size != OUT_TOTAL || ws_size < WS_END) { fprintf(stderr, "kernel_launch: unexpected shapes: n_in %d out %d ws %zu\n", n_in, out_size, ws_size); grid = -1; return; }
        int dev = 0, cus = 0, per_cu = 0;
        if (hipGetDevice(&dev) != hipSuccess || hipDeviceGetAttribute(&cus, hipDeviceAttributeMultiprocessorCount, dev) != hipSuccess) { grid = -1; return; }
        if (hipFuncSetAttribute((const void*)hybrid_fwd, hipFuncAttributeMaxDynamicSharedMemorySize, LDS_BYTES) != hipSuccess) { fprintf(stderr, "kernel_launch: hipFuncSetAttribute failed\n"); grid = -1; return; }
        if (hipOccupancyMaxActiveBlocksPerMultiprocessor(&per_cu, (const void*)hybrid_fwd, NWAVES * 64, LDS_BYTES) != hipSuccess || per_cu < 1) { fprintf(stderr, "kernel_launch: occupancy query says %d blocks per CU\n", per_cu); (void)hipGetLastError(); grid = -1; return; }
        grid = cus;
    }
    if (grid < 0) return;
    (void)hipMemsetAsync((char*)d_ws + WS_CTL, 0, CTL_ZERO_BYTES, stream);
    Args a{};
    for (int i = 0; i < 19; ++i) a.in[i] = (const float*)d_in[i];
    a.out = (float*)d_out; a.ws = (unsigned char*)d_ws;
#if MK_PER_PHASE
    for (int ph = 0; ph < N_PHASES; ++ph) { a.ph_lo = ph; a.ph_hi = ph + 1; hipLaunchKernelGGL(hybrid_fwd, dim3(grid), dim3(NWAVES * 64), LDS_BYTES, stream, a); }
#else
    a.ph_lo = 0; a.ph_hi = N_PHASES;
    hipLaunchKernelGGL(hybrid_fwd, dim3(grid), dim3(NWAVES * 64), LDS_BYTES, stream, a);
#endif
}
```
